# Optimizing an MI355X kernel written in HIP

```python
import jax, jax.numpy as jnp
from jax import lax
import numpy as np

D_MODEL = 2048
BATCH = 16
SEQ = 256
DEPTH = 1
DEC_BATCH = 8
DEC_SEQ = 2048
PAST_LEN = 256

GRID_W = 64
MLSTM_WIDTH = D_MODEL // 2
N_HEADS = 8
HEAD_DIM = MLSTM_WIDTH // N_HEADS
POOL_WIDTH = D_MODEL - MLSTM_WIDTH
POOL_WINDOWS = (2, 4, 8, 16)
N_POOL_GROUPS = len(POOL_WINDOWS)
POOL_GROUP_DIM = POOL_WIDTH // N_POOL_GROUPS
N_GATES = 4
PROJ_WIDTH = 4 * MLSTM_WIDTH + N_GATES * N_HEADS + POOL_WIDTH
D_FF = 4 * D_MODEL
CHUNK = 128
N_MOD = 6
EPS = 1e-6

kernel_name = "hymba_mlstm_pool_flow_step"


def _rmsnorm(x, w):
    xf = x.astype(jnp.float32)
    xf = xf * lax.rsqrt(jnp.mean(xf * xf, axis=-1, keepdims=True) + EPS)
    return (xf * w.astype(jnp.float32)).astype(x.dtype)


def _adaln(cond, ada_w, ada_b):
    mod = jax.nn.silu(cond) @ ada_w + ada_b
    return mod.reshape(cond.shape[0], N_MOD, D_MODEL)


def _mlstm_scan(q, k, v, li, lf, C0, n0, m0):
    B, T, H, Dh = q.shape
    nc = T // CHUNK

    def to_chunks(a):
        a = a.reshape((B, nc, CHUNK, H) + a.shape[3:])
        return jnp.moveaxis(a, (1, 3), (0, 2))

    mask = jnp.tril(jnp.ones((CHUNK, CHUNK), dtype=bool))

    def step(carry, xs):
        C, n, m = carry
        qc, kc, vc, lic, lfc = xs
        b = jnp.cumsum(lfc, axis=-1)
        dmat = jnp.where(mask, b[..., :, None] - b[..., None, :] + lic[..., None, :], -jnp.inf)
        m_inter = b + m[..., None]
        m_t = jnp.maximum(m_inter, jnp.max(dmat, axis=-1))
        s = jnp.einsum('bhtd,bhsd->bhts', qc, kc) * jnp.exp(dmat - m_t[..., None])
        g = jnp.exp(m_inter - m_t)
        num = g[..., None] * jnp.einsum('bhtd,bhde->bhte', qc, C) + jnp.einsum('bhts,bhse->bhte', s, vc)
        den = g * jnp.einsum('bhtd,bhd->bht', qc, n) + jnp.sum(s, axis=-1)
        h = num / jnp.maximum(jnp.abs(den), jnp.exp(-m_t))[..., None]
        b_last = b[..., -1]
        decay = b_last[..., None] - b + lic
        m_new = jnp.maximum(b_last + m, jnp.max(decay, axis=-1))
        wk = kc * jnp.exp(decay - m_new[..., None])[..., None]
        g_state = jnp.exp(b_last + m - m_new)
        C_new = g_state[..., None, None] * C + jnp.einsum('bhsd,bhse->bhde', wk, vc)
        n_new = g_state[..., None] * n + jnp.sum(wk, axis=2)
        return (C_new, n_new, m_new), h

    (C, n, m), h = lax.scan(step, (C0, n0, m0),
                            (to_chunks(q), to_chunks(k), to_chunks(v), to_chunks(li), to_chunks(lf)))
    h = jnp.moveaxis(h, (0, 2), (1, 3)).reshape(B, T, H, Dh)
    return h, C, n, m


def _mlstm_bidir(q, k, v, gates, C0, n0, m0):
    li_f = gates[:, :, 0]
    lf_f = jax.nn.log_sigmoid(gates[:, :, 1])
    li_b = gates[:, :, 2]
    lf_b = jax.nn.log_sigmoid(gates[:, :, 3])
    rev = lambda a: jnp.flip(a, axis=1)
    h_f, Cf, nf, mf = _mlstm_scan(q, k, v, li_f, lf_f, C0[:, 0], n0[:, 0], m0[:, 0])
    h_b, Cb, nb, mb = _mlstm_scan(rev(q), rev(k), rev(v), rev(li_b), rev(lf_b), C0[:, 1], n0[:, 1], m0[:, 1])
    h = h_f + rev(h_b)
    return h, jnp.stack([Cf, Cb], axis=1), jnp.stack([nf, nb], axis=1), jnp.stack([mf, mb], axis=1)


def _centred_pool_minus_self(x, window):
    L = x.shape[-2]
    xf = x.astype(jnp.float32)
    cs = jnp.cumsum(xf, axis=-2)
    cs = jnp.concatenate([jnp.zeros_like(cs[..., :1, :]), cs], axis=-2)
    t = jnp.arange(L)
    lo = jnp.maximum(t - window // 2, 0)
    hi = jnp.minimum(t + window // 2, L)
    total = jnp.take(cs, hi, axis=-2) - jnp.take(cs, lo, axis=-2)
    mean = total / (hi - lo).astype(jnp.float32)[:, None]
    return (mean - xf).astype(x.dtype)


def _pool_mixer(u, pool_w, pool_scale, grid_w):
    B, L, _ = u.shape
    if grid_w is not None:
        rows = L // grid_w
        u = u.reshape(B, rows, grid_w, POOL_WIDTH)
    groups = [_centred_pool_minus_self(u[..., gi * POOL_GROUP_DIM:(gi + 1) * POOL_GROUP_DIM], w)
              for gi, w in enumerate(POOL_WINDOWS)]
    p = jnp.stack(groups, axis=-2)
    y = jnp.einsum('...gc,gcd->...gd', p, pool_w).reshape(B, L, POOL_WIDTH)
    return y * pool_scale


def _layer(x, mod, C0, n0, m0, w_in, gate_bias, mlstm_norm_w, pool_w, pool_scale, w_out, norm_w, w1, w2, grid_w):
    B, T, _ = x.shape
    shift_a, scale_a, gate_a, shift_f, scale_f, gate_f = [mod[:, i][:, None, :] for i in range(N_MOD)]
    h = _rmsnorm(x, norm_w[0]) * (1 + scale_a) + shift_a
    proj = h @ w_in
    M = MLSTM_WIDTH
    q, k, v, o, g, u = jnp.split(proj, [M, 2 * M, 3 * M, 4 * M, 4 * M + N_GATES * N_HEADS], axis=-1)
    f32 = jnp.float32
    q = q.reshape(B, T, N_HEADS, HEAD_DIM).astype(f32) * (HEAD_DIM ** -0.5)
    k = k.reshape(B, T, N_HEADS, HEAD_DIM).astype(f32)
    v = v.reshape(B, T, N_HEADS, HEAD_DIM).astype(f32)
    gates = g.reshape(B, T, N_GATES, N_HEADS).astype(f32) + gate_bias.astype(f32)
    hm, C, n, m = _mlstm_bidir(q, k, v, gates, C0.astype(f32), n0.astype(f32), m0.astype(f32))
    hm = _rmsnorm(hm, mlstm_norm_w.reshape(N_HEADS, HEAD_DIM)).astype(x.dtype)
    hm = hm.reshape(B, T, M) * jax.nn.sigmoid(o)
    hp = _pool_mixer(u, pool_w, pool_scale, grid_w)
    mix = jnp.concatenate([hm, hp], axis=-1) @ w_out
    x = x + gate_a * _rmsnorm(mix, norm_w[1])
    h = _rmsnorm(x, norm_w[2]) * (1 + scale_f) + shift_f
    y = jnp.square(jax.nn.relu(h @ w1)) @ w2
    x = x + gate_f * _rmsnorm(y, norm_w[3])
    return x, C, n, m


def setup_inputs(seed: int = 0) -> dict:
    key = jax.random.key(seed)
    ks = jax.random.split(key, 20)
    nrm = jax.random.normal
    f32 = jnp.float32
    x_prompt = nrm(ks[0], (BATCH, SEQ, D_MODEL), f32)
    x_sample = nrm(ks[1], (DEC_BATCH, DEC_SEQ, D_MODEL), f32)
    c = nrm(ks[2], (DEC_BATCH, D_MODEL), f32)
    state_C = 0.5 * nrm(ks[3], (DEC_BATCH, DEPTH, 2, N_HEADS, HEAD_DIM, HEAD_DIM), f32)
    state_n = 0.5 * nrm(ks[4], (DEC_BATCH, DEPTH, 2, N_HEADS, HEAD_DIM), f32)
    state_m = 0.5 * nrm(ks[5], (DEC_BATCH, DEPTH, 2, N_HEADS), f32)
    c_ctx = nrm(ks[6], (D_MODEL,), f32)
    w_in = nrm(ks[7], (DEPTH, D_MODEL, PROJ_WIDTH), f32) * D_MODEL ** -0.5
    ib = 0.1 * nrm(ks[8], (DEPTH, 2, N_HEADS), f32)
    fb = jnp.linspace(3.0, 6.0, N_HEADS, dtype=f32) + 0.1 * nrm(ks[9], (DEPTH, 2, N_HEADS), f32)
    gate_bias = jnp.stack([ib[:, 0], fb[:, 0], ib[:, 1], fb[:, 1]], axis=1)
    mlstm_norm_w = 1.0 + 0.1 * nrm(ks[10], (DEPTH, MLSTM_WIDTH), f32)
    pool_w = nrm(ks[11], (DEPTH, N_POOL_GROUPS, POOL_GROUP_DIM, POOL_GROUP_DIM), f32) * POOL_GROUP_DIM ** -0.5
    pool_scale = 1.0 + 0.1 * nrm(ks[12], (DEPTH, POOL_WIDTH), f32)
    w_out = nrm(ks[13], (DEPTH, MLSTM_WIDTH + POOL_WIDTH, D_MODEL), f32) * (MLSTM_WIDTH + POOL_WIDTH) ** -0.5
    ada_w = nrm(ks[14], (DEPTH, D_MODEL, N_MOD * D_MODEL), f32) * (0.5 * D_MODEL ** -0.5)
    ada_b = 0.02 * nrm(ks[15], (DEPTH, N_MOD * D_MODEL), f32)
    norm_w = 1.0 + 0.1 * nrm(ks[16], (DEPTH, 4, D_MODEL), f32)
    w1 = nrm(ks[17], (DEPTH, D_MODEL, D_FF), f32) * D_MODEL ** -0.5
    w2 = nrm(ks[18], (DEPTH, D_FF, D_MODEL), f32) * D_FF ** -0.5
    return {"x_prompt": x_prompt, "x_sample": x_sample, "c": c,
            "state_C": state_C, "state_n": state_n, "state_m": state_m,
            "c_ctx": c_ctx, "w_in": w_in, "gate_bias": gate_bias, "mlstm_norm_w": mlstm_norm_w,
            "pool_w": pool_w, "pool_scale": pool_scale, "w_out": w_out,
            "ada_w": ada_w, "ada_b": ada_b, "norm_w": norm_w, "w1": w1, "w2": w2}


def reference(x_prompt, x_sample, c, state_C, state_n, state_m, c_ctx, w_in, gate_bias, mlstm_norm_w,
              pool_w, pool_scale, w_out, ada_w, ada_b, norm_w, w1, w2):
    B = x_prompt.shape[0]
    yp = x_prompt
    ys = x_sample
    new_C, new_n, new_m = [], [], []
    for layer in range(DEPTH):
        params = (w_in[layer], gate_bias[layer], mlstm_norm_w[layer], pool_w[layer], pool_scale[layer],
                  w_out[layer], norm_w[layer], w1[layer], w2[layer])
        mod_ctx = _adaln(c_ctx[None, :], ada_w[layer], ada_b[layer])
        C0 = jnp.zeros((B, 2, N_HEADS, HEAD_DIM, HEAD_DIM), jnp.float32)
        n0 = jnp.zeros((B, 2, N_HEADS, HEAD_DIM), jnp.float32)
        m0 = jnp.zeros((B, 2, N_HEADS), jnp.float32)
        yp, Cc, nc_, mc = _layer(yp, mod_ctx, C0, n0, m0, *params, None)
        new_C.append(Cc)
        new_n.append(nc_)
        new_m.append(mc)
        mod_lat = _adaln(c, ada_w[layer], ada_b[layer])
        ys, _, _, _ = _layer(ys, mod_lat, state_C[:, layer], state_n[:, layer], state_m[:, layer], *params, GRID_W)
    new_state_C = jnp.stack(new_C, axis=1)
    new_state_n = jnp.stack(new_n, axis=1)
    new_state_m = jnp.stack(new_m, axis=1)
    return (yp, ys, new_state_C, new_state_n, new_state_m)
```

```cpp
#include <hip/hip_runtime.h>
#include <cstdio>
#include <cstdint>

#ifndef MK_N_LAUNCHES
#define MK_N_LAUNCHES 1
#endif

namespace pg8 {
#define PG8_LAS __attribute__((address_space(3)))
typedef unsigned short bf16_t;
typedef short bf16x8 __attribute__((ext_vector_type(8)));
typedef float f32x4 __attribute__((ext_vector_type(4)));
typedef unsigned u32x4 __attribute__((ext_vector_type(4)));
typedef unsigned u32x2 __attribute__((ext_vector_type(2)));
typedef int v8i __attribute__((ext_vector_type(8)));
typedef int v4i __attribute__((ext_vector_type(4)));
typedef short s16x16a __attribute__((ext_vector_type(16), aligned(16)));
constexpr int BM = 256, BK = 64, HALF = 128, HTB = HALF * BK * 2, STAGE_BYTES = 8 * HTB, NXCD = 8, WGM = 8;

__host__ __device__ __forceinline__ int lds_byte(int r, int c) { const int st = (r >> 4) * 2 + (c >> 5), rr = r & 15, cc = c & 31, ob = rr * 64 + cc * 2; return st * 1024 + (ob ^ (((ob >> 9) & 1) << 5)); }
__host__ __device__ __forceinline__ void stage_rc(int b, int& R, int& C) { const int st = b / 1024, sb = b % 1024, swz = sb ^ (((sb >> 9) & 1) << 5); R = (st >> 1) * 16 + swz / 64; C = (st & 1) * 32 + (swz % 64) / 2; }
__host__ __device__ __forceinline__ int perm32(int rho) { const int n = rho >> 4, i = rho & 15; return 8 * (i >> 2) + 4 * n + (i & 3); }

struct Unit { int pm, pn, ka, kb; };
struct Gemm { const bf16_t* A; const bf16_t* Bt; int K, lda, ldb; unsigned sc8; };

struct StaticOrder {
    int nM, nN, nwg, G, c;
    __host__ __device__ void init(int M, int N, int G_, int c_) { nM = M / BM; nN = N / BM; nwg = nM * nN; G = G_; c = c_; }
    __host__ __device__ bool next(int i, Unit& u) const {
        const long L = (long)i * G + c; if (L >= nwg) return false;
        int wgid = (int)L; { const int q = nwg / NXCD, r = nwg % NXCD, xcd = wgid % NXCD, off = wgid / NXCD; wgid = (xcd < r ? xcd * (q + 1) : r * (q + 1) + (xcd - r) * q) + off; }
        const int nig = WGM * nN, gid = wgid / nig, fm = gid * WGM, gsz = (nM - fm) < WGM ? (nM - fm) : WGM;
        u.pm = fm + ((wgid % nig) % gsz); u.pn = (wgid % nig) / gsz; u.ka = 0; u.kb = 0; return true;
    }
};
struct SplitTail {
    int pm0, nMt, kh_len, G, c;
    __host__ __device__ bool next(int i, Unit& u) const {
        const int ntile = nMt * 8; const long L = (long)i * G + c; if (L >= 2 * ntile) return false;
        const int kh = (int)L / ntile; int wgid = (int)L % ntile; { const int q = ntile / NXCD, xcd = wgid % NXCD, off = wgid / NXCD; wgid = xcd * q + off; }
        const int nig = WGM * 8, gid = wgid / nig, fm = gid * WGM, gsz = (nMt - fm) < WGM ? (nMt - fm) : WGM;
        u.pm = pm0 + fm + ((wgid % nig) % gsz); u.pn = (wgid % nig) / gsz; u.ka = kh * kh_len; u.kb = kh * kh_len; return true;
    }
};
struct OneUnit {
    Unit u;
    __host__ __device__ bool next(int i, Unit& o) const { if (i) return false; o = u; return true; }
};

typedef __bf16 bf16x2_t __attribute__((ext_vector_type(2)));
__device__ __forceinline__ unsigned cvt_pk_bf16(float lo, float hi) { const bf16x2_t v = {(__bf16)lo, (__bf16)hi}; return __builtin_bit_cast(unsigned, v); }

struct EpiProj {
    static constexpr bool PERM = true;
    bf16_t* P; float* G; int ntok;
    __device__ __forceinline__ void operator()(const f32x4 (&acc)[2][2][4][2], const Unit& u, int wr, int wc, int fr, int fq) const {
        const int row0 = u.pm * BM + wr * 64 + fr;
        if (u.pn < 20) {
            const int col0 = u.pn * BM + wc * 32 + 8 * fq;
#pragma unroll
            for (int ai = 0; ai < 2; ++ai)
#pragma unroll
                for (int m = 0; m < 4; ++m) { bf16_t* rowp = P + (size_t)(row0 + ai * HALF + m * 16) * 5120 + col0;
#pragma unroll
                    for (int bj = 0; bj < 2; ++bj) { const f32x4 v0 = acc[ai][bj][m][0], v1 = acc[ai][bj][m][1];
                        u32x4 w; w.x = cvt_pk_bf16(v0[0], v0[1]); w.y = cvt_pk_bf16(v0[2], v0[3]); w.z = cvt_pk_bf16(v1[0], v1[1]); w.w = cvt_pk_bf16(v1[2], v1[3]);
                        *(u32x4*)(rowp + bj * HALF) = w; } }
        } else if (wc == 0) {
#pragma unroll
            for (int ai = 0; ai < 2; ++ai)
#pragma unroll
                for (int m = 0; m < 4; ++m) { float* gp = G + (size_t)(8 * fq) * ntok + (row0 + ai * HALF + m * 16);
#pragma unroll
                    for (int n = 0; n < 2; ++n)
#pragma unroll
                        for (int j = 0; j < 4; ++j) gp[(size_t)(4 * n + j) * ntok] = acc[ai][0][m][n][j]; }
        }
    }
};
template <int ACT, bool SPLIT, bool SCALE = true> struct EpiBf16 {
    static constexpr bool PERM = true;
    bf16_t* O; int ldc; bf16_t* O2; int pm0; float oscale;
    __device__ __forceinline__ void operator()(const f32x4 (&acc)[2][2][4][2], const Unit& u, int wr, int wc, int fr, int fq) const {
        const int col0 = u.pn * BM + wc * 32 + 8 * fq;
        bf16_t* base = O + (size_t)(u.pm * BM + wr * 64 + fr) * ldc + col0;
        if (SPLIT) { if (u.ka != 0) base = O2 + (size_t)((u.pm - pm0) * BM + wr * 64 + fr) * ldc + col0; }
#pragma unroll
        for (int ai = 0; ai < 2; ++ai)
#pragma unroll
            for (int m = 0; m < 4; ++m) { bf16_t* rowp = base + (size_t)(ai * HALF + m * 16) * ldc;
#pragma unroll
                for (int bj = 0; bj < 2; ++bj) { f32x4 v0 = acc[ai][bj][m][0], v1 = acc[ai][bj][m][1];
                    if (SCALE) { v0 = v0 * oscale; v1 = v1 * oscale; }
                    if (ACT == 1) {
#pragma unroll
                        for (int j = 0; j < 4; ++j) { const float a = fmaxf(v0[j], 0.f), b = fmaxf(v1[j], 0.f); v0[j] = a * a; v1[j] = b * b; } }
                    u32x4 w; w.x = cvt_pk_bf16(v0[0], v0[1]); w.y = cvt_pk_bf16(v0[2], v0[3]); w.z = cvt_pk_bf16(v1[0], v1[1]); w.w = cvt_pk_bf16(v1[2], v1[3]);
                    *(u32x4*)(rowp + bj * HALF) = w; } }
    }
};

struct EpiF8Relu2 {
    static constexpr bool PERM = true;
    unsigned char* O; int ldc;
    __device__ __forceinline__ void operator()(const f32x4 (&acc)[2][2][4][2], const Unit& u, int wr, int wc, int fr, int fq) const {
        unsigned char* base = O + (size_t)(u.pm * BM + wr * 64 + fr) * ldc + u.pn * BM + wc * 64 + 16 * fq;
#pragma unroll
        for (int ai = 0; ai < 2; ++ai)
#pragma unroll
            for (int m = 0; m < 4; ++m) { unsigned w[4];
#pragma unroll
                for (int bj = 0; bj < 2; ++bj) { f32x4 v0 = acc[ai][bj][m][0], v1 = acc[ai][bj][m][1];
#pragma unroll
                    for (int j = 0; j < 4; ++j) { v0[j] = __builtin_amdgcn_fmed3f(v0[j], 0.f, 21.16f); v1[j] = __builtin_amdgcn_fmed3f(v1[j], 0.f, 21.16f); }
                    v0 = v0 * v0; v1 = v1 * v1;
                    int w0 = __builtin_amdgcn_cvt_pk_fp8_f32(v0[0], v0[1], 0, false); w0 = __builtin_amdgcn_cvt_pk_fp8_f32(v0[2], v0[3], w0, true);
                    int w1 = __builtin_amdgcn_cvt_pk_fp8_f32(v1[0], v1[1], 0, false); w1 = __builtin_amdgcn_cvt_pk_fp8_f32(v1[2], v1[3], w1, true);
                    w[2 * bj] = (unsigned)w0; w[2 * bj + 1] = (unsigned)w1; }
                *(u32x4*)(base + (size_t)(ai * HALF + m * 16) * ldc) = (u32x4){w[0], w[1], w[2], w[3]}; }
    }
};

template <class E_> constexpr bool perm16_v = false;
template <> constexpr bool perm16_v<EpiF8Relu2> = true;
template <class Epi, class Sched, bool ALIGN_EPI = false, bool SP2 = false, bool F8 = false>
__device__ __forceinline__ void gemm_phase(PG8_LAS unsigned char* lds, const Gemm g, const Sched& S, const Epi& E) {
    const int tid = threadIdx.x, wid = __builtin_amdgcn_readfirstlane(tid >> 6), lane = tid & 63, wr = wid >> 2, wc = wid & 3, fr = lane & 15, fq = lane >> 4;
    constexpr int ES = F8 ? 1 : 2;
    const int K = g.K, nt = K * ES / (BK * 2);
    unsigned voffA[2], voffB[2];
#pragma unroll
    for (int i = 0; i < 2; ++i) { int R, C; stage_rc(tid * 16 + i * 8192, R, C);
        const int Rb = perm16_v<Epi> ? (64 * (R >> 5) + 16 * ((R >> 2) & 3) + 4 * ((R >> 4) & 1) + (R & 3)) : (Epi::PERM ? ((R & ~31) + perm32(R & 31)) : R);
        voffA[i] = (unsigned)(R * g.lda * ES + C * 2); voffB[i] = (unsigned)(Rb * g.ldb * ES + C * 2); }
    const size_t kstep = (size_t)(BK * 2);
    const size_t hstepA = (size_t)HALF * g.lda * ES, hstepB = (size_t)(perm16_v<Epi> ? 8 : HALF) * g.ldb * ES;
    const unsigned ldsw = (unsigned)wid * 1024u;
    const int aoff = lds_byte(wr * 64 + fr, fq * 8), boff = lds_byte(wc * 32 + fr, fq * 8);
#define PG8_UA(u) ((const char*)g.A + ((size_t)(u).pm * BM * g.lda + (size_t)(u).ka) * ES)
#define PG8_UB(u) ((const char*)g.Bt + ((size_t)(u).pn * BM * g.ldb + (size_t)(u).kb) * ES)
#define PG8_SA(b, h) (((b) * 2 + (h)) * HTB)
#define PG8_SB(b, h) ((4 + (b) * 2 + (h)) * HTB)
#define PG8_STAGE(bufoff, gbase, voff) do { _Pragma("unroll") for (int _i = 0; _i < 2; ++_i) \
        __builtin_amdgcn_global_load_lds((const unsigned*)((const char*)(gbase) + (voff)[_i]), (PG8_LAS unsigned*)(lds + (bufoff) + ldsw + _i * 8192), 16, 0, 0); } while (0)
#define PG8_LDA(dst, b, h) do { if constexpr (F8) { _Pragma("unroll") for (int m = 0; m < 4; ++m) dst##8[m] = __builtin_shufflevector(*(const PG8_LAS bf16x8*)(lds + PG8_SA(b, h) + aoff + m * 2048), *(const PG8_LAS bf16x8*)(lds + PG8_SA(b, h) + aoff + m * 2048 + 1024), 0, 1, 2, 3, 4, 5, 6, 7, 8, 9, 10, 11, 12, 13, 14, 15); } \
        else { _Pragma("unroll") for (int m = 0; m < 4; ++m) _Pragma("unroll") for (int k = 0; k < 2; ++k) dst[m][k] = *(const PG8_LAS bf16x8*)(lds + PG8_SA(b, h) + aoff + m * 2048 + k * 1024); } } while (0)
#define PG8_LDB(dst, b, h) do { if constexpr (F8) { _Pragma("unroll") for (int n = 0; n < 2; ++n) dst##8[n] = __builtin_shufflevector(*(const PG8_LAS bf16x8*)(lds + PG8_SB(b, h) + boff + n * 2048), *(const PG8_LAS bf16x8*)(lds + PG8_SB(b, h) + boff + n * 2048 + 1024), 0, 1, 2, 3, 4, 5, 6, 7, 8, 9, 10, 11, 12, 13, 14, 15); } \
        else { _Pragma("unroll") for (int n = 0; n < 2; ++n) _Pragma("unroll") for (int k = 0; k < 2; ++k) dst[n][k] = *(const PG8_LAS bf16x8*)(lds + PG8_SB(b, h) + boff + n * 2048 + k * 1024); } } while (0)
#define PG8_MMA(ai, bj, At, Bt) do { __builtin_amdgcn_s_setprio(1); _Pragma("unroll") for (int m = 0; m < 4; ++m) _Pragma("unroll") for (int n = 0; n < 2; ++n) { \
        if constexpr (F8) asm volatile("v_mfma_scale_f32_16x16x128_f8f6f4 %0, %1, %2, %0, %3, %3 op_sel_hi:[0,0,0]" : "+v"(acc[ai][bj][m][n]) : "v"(Bt##8[n]), "v"(At##8[m]), "v"(scv)); \
        else { _Pragma("unroll") for (int k = 0; k < 2; ++k) acc[ai][bj][m][n] = __builtin_amdgcn_mfma_f32_16x16x32_bf16(Bt[n][k], At[m][k], acc[ai][bj][m][n], 0, 0, 0); } } \
        __builtin_amdgcn_s_setprio(0); } while (0)
#define PG8_WAIT_V(n) asm volatile("s_waitcnt vmcnt(" #n ")" ::: "memory")
#define PG8_WAIT_L(n) asm volatile("s_waitcnt lgkmcnt(" #n ")" ::: "memory")
#define PG8_BAR __builtin_amdgcn_s_barrier()
#define PG8_SCHED __builtin_amdgcn_sched_barrier(0)
    Unit cur, nxt; int ui = 0; const unsigned scv = g.sc8;
    if (!S.next(0, cur)) return;
    f32x4 acc[2][2][4][2];
#pragma unroll
    for (int a = 0; a < 2; ++a)
#pragma unroll
        for (int b = 0; b < 2; ++b)
#pragma unroll
            for (int m = 0; m < 4; ++m)
#pragma unroll
                for (int n = 0; n < 2; ++n) acc[a][b][m][n] = (f32x4){0.f, 0.f, 0.f, 0.f};
    bf16x8 At[4][2], B0[2][2], B1[2][2]; s16x16a At8[4], B08[2], B18[2];
    const char* cA = PG8_UA(cur); const char* cB = PG8_UB(cur);
    if constexpr (SP2) {
        PG8_STAGE(PG8_SB(0, 0), cB, voffB); PG8_STAGE(PG8_SB(0, 1), cB + hstepB, voffB); PG8_STAGE(PG8_SA(0, 0), cA, voffA); PG8_STAGE(PG8_SA(0, 1), cA + hstepA, voffA);
        if (wr == 1) PG8_BAR;
        PG8_WAIT_V(2); PG8_BAR;
        PG8_STAGE(PG8_SB(1, 0), cB + kstep, voffB); PG8_STAGE(PG8_SA(1, 0), cA + kstep, voffA); PG8_STAGE(PG8_SB(1, 1), cB + hstepB + kstep, voffB);
        PG8_WAIT_V(6); PG8_BAR;
    } else {
        PG8_STAGE(PG8_SB(0, 0), cB, voffB); PG8_STAGE(PG8_SA(0, 0), cA, voffA); PG8_STAGE(PG8_SB(0, 1), cB + hstepB, voffB); PG8_STAGE(PG8_SA(0, 1), cA + hstepA, voffA);
        if (wr == 1) PG8_BAR;
        PG8_WAIT_V(4); PG8_BAR;
        PG8_STAGE(PG8_SB(1, 0), cB + kstep, voffB); PG8_STAGE(PG8_SA(1, 0), cA + kstep, voffA); PG8_STAGE(PG8_SB(1, 1), cB + hstepB + kstep, voffB);
        PG8_WAIT_V(6); PG8_BAR;
    }
    for (;;) {
        const bool has_next = S.next(ui + 1, nxt);
        const char* nA = has_next ? PG8_UA(nxt) : cA; const char* nB = has_next ? PG8_UB(nxt) : cB;
        for (int t = 0; t < nt; t += 2) {
            const bool last = (t == nt - 2);
            const char* a1 = cA + (size_t)(t + 1) * kstep;
            const char* a2 = last ? nA : cA + (size_t)(t + 2) * kstep; const char* b2 = last ? nB : cB + (size_t)(t + 2) * kstep;
            const char* a3 = a2 + kstep; const char* b3 = b2 + kstep;
            if constexpr (SP2) {
            PG8_LDB(B0, 0, 0); PG8_LDB(B1, 0, 1); PG8_SCHED; PG8_LDA(At, 0, 0); PG8_STAGE(PG8_SA(1, 1), a1 + hstepA, voffA);
            PG8_WAIT_V(8); PG8_WAIT_L(0); PG8_BAR; PG8_MMA(0, 0, At, B0); PG8_MMA(0, 1, At, B1); PG8_BAR; PG8_SCHED;
            PG8_LDA(At, 0, 1); PG8_STAGE(PG8_SB(0, 0), b2, voffB); PG8_STAGE(PG8_SB(0, 1), b2 + hstepB, voffB); PG8_STAGE(PG8_SA(0, 0), a2, voffA);
            PG8_WAIT_V(8); PG8_WAIT_L(0); PG8_BAR; PG8_MMA(1, 0, At, B0); PG8_MMA(1, 1, At, B1); PG8_BAR; PG8_SCHED;
            PG8_LDB(B0, 1, 0); PG8_LDB(B1, 1, 1); PG8_SCHED; PG8_LDA(At, 1, 0); PG8_STAGE(PG8_SA(0, 1), a2 + hstepA, voffA);
            PG8_WAIT_V(8); PG8_WAIT_L(0); PG8_BAR; PG8_MMA(0, 0, At, B0); PG8_MMA(0, 1, At, B1); PG8_BAR; PG8_SCHED;
            PG8_LDA(At, 1, 1); PG8_STAGE(PG8_SB(1, 0), b3, voffB); PG8_STAGE(PG8_SB(1, 1), b3 + hstepB, voffB); PG8_STAGE(PG8_SA(1, 0), a3, voffA);
            PG8_WAIT_V(8); PG8_WAIT_L(0); PG8_BAR; PG8_MMA(1, 0, At, B0); PG8_MMA(1, 1, At, B1); PG8_BAR; PG8_SCHED;
            } else {
            PG8_LDB(B0, 0, 0); PG8_SCHED; PG8_LDA(At, 0, 0); PG8_STAGE(PG8_SA(1, 1), a1 + hstepA, voffA);
            PG8_WAIT_L(8); PG8_BAR; PG8_WAIT_L(0); PG8_MMA(0, 0, At, B0); PG8_BAR; PG8_SCHED;
            PG8_LDB(B1, 0, 1); PG8_STAGE(PG8_SB(0, 0), b2, voffB);
            PG8_BAR; PG8_WAIT_L(0); PG8_MMA(0, 1, At, B1); PG8_BAR;
            PG8_LDA(At, 0, 1); PG8_STAGE(PG8_SA(0, 0), a2, voffA);
            PG8_BAR; PG8_WAIT_L(0); PG8_MMA(1, 0, At, B0); PG8_BAR; PG8_SCHED;
            PG8_STAGE(PG8_SB(0, 1), b2 + hstepB, voffB);
            PG8_WAIT_V(6); PG8_BAR; PG8_MMA(1, 1, At, B1); PG8_BAR;
            PG8_LDB(B0, 1, 0); PG8_SCHED; PG8_LDA(At, 1, 0); PG8_STAGE(PG8_SA(0, 1), a2 + hstepA, voffA);
            PG8_WAIT_L(8); PG8_BAR; PG8_WAIT_L(0); PG8_MMA(0, 0, At, B0); PG8_BAR; PG8_SCHED;
            PG8_LDB(B1, 1, 1); PG8_STAGE(PG8_SB(1, 0), b3, voffB);
            PG8_BAR; PG8_WAIT_L(0); PG8_MMA(0, 1, At, B1); PG8_BAR;
            PG8_LDA(At, 1, 1); PG8_STAGE(PG8_SA(1, 0), a3, voffA);
            PG8_BAR; PG8_WAIT_L(0); PG8_MMA(1, 0, At, B0); PG8_BAR; PG8_SCHED;
            PG8_STAGE(PG8_SB(1, 1), b3 + hstepB, voffB);
            PG8_WAIT_V(6); PG8_BAR; PG8_MMA(1, 1, At, B1); PG8_BAR;
            }
        }
        if constexpr (ALIGN_EPI) { if (wr == 0) PG8_BAR; }
        if constexpr (F8) asm volatile("s_nop 15\n\ts_nop 15" ::: "memory");
        E(acc, cur, wr, wc, fr, fq);
        if (!has_next) break;
#pragma unroll
        for (int a = 0; a < 2; ++a)
#pragma unroll
            for (int b = 0; b < 2; ++b)
#pragma unroll
                for (int m = 0; m < 4; ++m)
#pragma unroll
                    for (int n = 0; n < 2; ++n) acc[a][b][m][n] = (f32x4){0.f, 0.f, 0.f, 0.f};
        cur = nxt; cA = nA; cB = nB; ++ui;
        if constexpr (ALIGN_EPI) { if (wr == 1) PG8_BAR; }
    }
    PG8_WAIT_V(0);
    if constexpr (!ALIGN_EPI) { if (wr == 0) PG8_BAR; }
    PG8_BAR;
#undef PG8_UA
#undef PG8_UB
#undef PG8_SA
#undef PG8_SB
#undef PG8_STAGE
#undef PG8_LDA
#undef PG8_LDB
#undef PG8_MMA
#undef PG8_WAIT_V
#undef PG8_WAIT_L
#undef PG8_BAR
#undef PG8_SCHED
}
}

constexpr int NWAVES = 8;
constexpr int N_LAUNCHES = MK_N_LAUNCHES;
constexpr int PER_PHASE = 10;
constexpr int D = 2048, NCTX = 16 * 256, NLAT = 8 * 2048, NTOK = NCTX + NLAT;
constexpr int MW = 1024, NH = 8, DH = 128, PW = 1024, FF = 8192;
constexpr int PROJ_LD = 5120;
constexpr int WIN_ROWS = 5376;
constexpr float EPS = 1e-6f;
constexpr int NMOD = 9;

constexpr size_t MiB = 1u << 20;
constexpr size_t WS_CTL = 0, CTL_ZERO_BYTES = 1 * MiB;
constexpr size_t WS_MOD = 1 * MiB;
constexpr size_t WS_GATES = 2 * MiB;
constexpr int TAIL_PM0 = 64, TAIL_NM = 16;
constexpr size_t WS_POOLWT = 11 * MiB;
constexpr size_t WS_WU = 5 * MiB;
constexpr size_t WS_WIN = 12 * MiB;
constexpr size_t WS_WOUT = 33 * MiB;
constexpr size_t WS_W1 = 41 * MiB;
constexpr size_t WS_W2 = 73 * MiB;
constexpr size_t WS_RB = 108 * MiB;
constexpr size_t WS_PROJ = 188 * MiB;
constexpr size_t WS_HDIR = 388 * MiB;
constexpr size_t WS_PP = 468 * MiB;
constexpr size_t WS_HFF = 188 * MiB;
constexpr size_t WS_END = 508 * MiB;
constexpr int CW_TMO = 0, CW_CODE = 1;
constexpr int CW_BAR = 4096;

constexpr int RING_OFF = 0;
constexpr int KLD = 144, VLD = 80;
constexpr int ML_KB = 0, ML_KB_SZ = 36864;
constexpr int ML_VB = 73728, ML_VB_SZ = 20480;
constexpr int ML_CT = 114688, ML_CT_SZ = 18944;
constexpr int ML_G = 154112, ML_G_SZ = 2048;
constexpr int ML_SC = 158208;
constexpr int LDSCTL_OFF = 158720, MISC_OFF = LDSCTL_OFF + 320;
constexpr int LDS_BYTES = 159744;

#define GAS __attribute__((address_space(1)))
#define LAS __attribute__((address_space(3)))
typedef unsigned short bf16;
typedef unsigned v4u __attribute__((ext_vector_type(4)));
typedef unsigned v2u __attribute__((ext_vector_type(2)));
typedef float f32x4 __attribute__((ext_vector_type(4)));
typedef short bf16x8 __attribute__((ext_vector_type(8)));
typedef GAS unsigned gu32;
#define RLX_AGENT __ATOMIC_RELAXED, __HIP_MEMORY_SCOPE_AGENT
#define LDS_WAIT() asm volatile("s_waitcnt lgkmcnt(0)" ::: "memory")
#define VM_WAIT() asm volatile("s_waitcnt vmcnt(0)" ::: "memory")
typedef __bf16 bf16x2_t __attribute__((ext_vector_type(2)));
__device__ __forceinline__ unsigned pk2(float lo, float hi) { const bf16x2_t v = {(__bf16)lo, (__bf16)hi}; return __builtin_bit_cast(unsigned, v); }
__device__ __forceinline__ float bflo(unsigned w) { return __uint_as_float(w << 16); }
__device__ __forceinline__ float bfhi(unsigned w) { return __uint_as_float(w & 0xffff0000u); }
__device__ __forceinline__ float bf2f(bf16 b) { return __uint_as_float((unsigned)b << 16); }

#define XB_TMO      128
#define XB_XCNT(j)  (256  + 64 * (j))
#define XB_XSUB(j)  (1280 + 64 * (j))
#define XB_XGEN(j)  (2304 + 64 * (j))
#define XB_TOP      3328
#define XB_TOPGEN   3392
#define XCD_BAR_WORDS 3456
#define XB_SPIN_CAP (1u << 18)
__device__ __forceinline__ unsigned xb_ld(unsigned* p)              { return __hip_atomic_load(p, __ATOMIC_RELAXED, __HIP_MEMORY_SCOPE_AGENT); }
__device__ __forceinline__ unsigned xb_add(unsigned* p, unsigned v) { return __hip_atomic_fetch_add(p, v, __ATOMIC_RELAXED, __HIP_MEMORY_SCOPE_AGENT); }
__device__ __forceinline__ unsigned xb_xcc_id() { return (unsigned)__builtin_amdgcn_s_getreg((3 << 11) | 20) & 0xFu; }
#define XB_SPIN(cond, bar) do { unsigned _sp = 0; while (cond) { __builtin_amdgcn_s_sleep(1); \
    if ((++_sp & 255u) == 0u) { if (xb_ld(&(bar)[XB_TMO])) break; if (_sp > XB_SPIN_CAP) { atomicAdd(&(bar)[XB_TMO], 1u); break; } } } } while (0)
struct XcdBarrier { unsigned* bar; unsigned x; volatile LAS unsigned* st; };
__device__ __forceinline__ XcdBarrier xcd_barrier_post(unsigned* bar, volatile LAS unsigned* st) {
    XcdBarrier b; b.bar = bar; b.x = xb_xcc_id(); b.st = st;
    if (threadIdx.x == 0) (void)xb_add(&bar[XB_XCNT(b.x)], 1u);
    return b;
}
__device__ __forceinline__ void xcd_barrier_complete(unsigned* bar, unsigned x, unsigned& nloc, unsigned& nx) {
    const unsigned G = gridDim.x * gridDim.y * gridDim.z;
    unsigned sum, cnt, mine, sp = 0u;
    for (;;) {
        sum = 0u; cnt = 0u; mine = 0u;
#pragma unroll
        for (unsigned j = 0; j < 16; ++j) { const unsigned c = xb_ld(&bar[XB_XCNT(j)]); sum += c; cnt += (c > 0u) ? 1u : 0u; mine = (j == x) ? c : mine; }
        if (sum == G) break;
        __builtin_amdgcn_s_sleep(1);
        if ((++sp & 255u) == 0u) { if (xb_ld(&bar[XB_TMO])) break; if (sp > XB_SPIN_CAP) { atomicAdd(&bar[XB_TMO], 1u); break; } }
    }
    nloc = mine > 0u ? mine : 1u; nx = cnt > 0u ? cnt : 1u;
}
__device__ __forceinline__ void xcd_barrier(const XcdBarrier& b) {
    asm volatile("s_waitcnt vmcnt(0)" ::: "memory");
    __syncthreads();
    if (threadIdx.x == 0) {
        unsigned* bar = b.bar;
        __builtin_amdgcn_s_waitcnt(0);
        unsigned nloc = b.st[0], nx = b.st[1];
        if (nloc == 0u) { xcd_barrier_complete(bar, b.x, nloc, nx); b.st[0] = nloc; b.st[1] = nx; }
        const unsigned old = xb_add(&bar[XB_XSUB(b.x)], 1u);
        const unsigned gen = old / nloc;
        if (old + 1u == (gen + 1u) * nloc) {
            __builtin_amdgcn_fence(__ATOMIC_RELEASE, "agent");
            asm volatile("s_waitcnt vmcnt(0)" ::: "memory");
            const unsigned og = xb_add(&bar[XB_TOP], 1u);
            const unsigned tg = og / nx;
            if (og + 1u == (tg + 1u) * nx) xb_add(&bar[XB_TOPGEN], 1u);
            else XB_SPIN(xb_ld(&bar[XB_TOPGEN]) == tg, bar);
            __builtin_amdgcn_fence(__ATOMIC_ACQUIRE, "agent");
            xb_add(&bar[XB_XGEN(b.x)], 1u);
            asm volatile("s_waitcnt vmcnt(0)" ::: "memory");
        } else {
            XB_SPIN(xb_ld(&bar[XB_XGEN(b.x)]) == gen, bar);
            __builtin_amdgcn_fence(__ATOMIC_ACQUIRE, "agent");
            asm volatile("s_waitcnt vmcnt(0)" ::: "memory");
        }
    }
    __syncthreads();
}

struct Args { const float* in[18]; float* out; unsigned char* ws; int ph_lo, ph_hi, li, pad; };
struct Frame {
    LAS unsigned char* lds;
    volatile LAS unsigned* MISC;
    int tid, lane, wave;
    int vcu, G;
    const Args* a;
};
#define F_xp (F.a->in[0])
#define F_xs (F.a->in[1])
#define F_cc (F.a->in[2])
#define F_stC (F.a->in[3])
#define F_stN (F.a->in[4])
#define F_stM (F.a->in[5])
#define F_cctx (F.a->in[6])
#define F_w_in (F.a->in[7])
#define F_gate_bias (F.a->in[8])
#define F_mnw (F.a->in[9])
#define F_pool_w (F.a->in[10])
#define F_pool_scale (F.a->in[11])
#define F_w_out (F.a->in[12])
#define F_ada_w (F.a->in[13])
#define F_ada_b (F.a->in[14])
#define F_norm_w (F.a->in[15])
#define F_w1 (F.a->in[16])
#define F_w2 (F.a->in[17])
#define F_out (F.a->out)
#define F_ctl ((gu32*)(F.a->ws + WS_CTL))
#define F_MOD ((float*)(F.a->ws + WS_MOD))
#define F_GATES ((float*)(F.a->ws + WS_GATES))
#define F_MIX1 ((bf16*)(F.a->ws + WS_PP))
#define F_Y1 ((bf16*)(F.a->ws + WS_WIN))
#define F_PoolWT ((bf16*)(F.a->ws + WS_POOLWT))
#define F_WU ((bf16*)(F.a->ws + WS_WU))
#define F_WinT ((bf16*)(F.a->ws + WS_WIN))
#define F_WoutT ((bf16*)(F.a->ws + WS_WOUT))
#define F_W1T ((bf16*)(F.a->ws + WS_W1))
#define F_W2T ((bf16*)(F.a->ws + WS_W2))
#define F_RB ((bf16*)(F.a->ws + WS_RB))
#define F_PROJ ((bf16*)(F.a->ws + WS_PROJ))
#define F_HDIR ((bf16*)(F.a->ws + WS_HDIR))
#define F_HFF ((bf16*)(F.a->ws + WS_HFF))

__device__ __forceinline__ int fresh_lane() { int l; asm volatile("v_mbcnt_lo_u32_b32 %0, -1, 0\n\tv_mbcnt_hi_u32_b32 %0, -1, %0" : "=v"(l)); return l; }
__device__ __forceinline__ float wave_sum(float v) {
#pragma unroll
    for (int o = 1; o < 64; o <<= 1) v += __shfl_xor(v, o);
    return v;
}
__device__ __forceinline__ const float* xrow_ptr(const Frame& F, int m) { return m < NCTX ? F_xp + (size_t)m * D : F_xs + (size_t)(m - NCTX) * D; }
__device__ __forceinline__ int modrow(int m) { return m < NCTX ? 0 : 1 + ((m - NCTX) >> 11); }

constexpr float W1_SCALE = 32.f, H2_SCALE = 8.f;
__device__ __forceinline__ void p0_transpose_item(const float* W, int N, bf16* WT, int ldk, int k0, int n0, int drow0, LAS float* scr, int lane, const float* nscale = nullptr, float cscale = 1.f) {
    { const int kr = lane >> 3, nq = lane & 7; f32x4 v[8];
#pragma unroll
        for (int i = 0; i < 8; ++i) v[i] = __builtin_nontemporal_load((const GAS f32x4*)(W + (size_t)(k0 + 8 * i + kr) * N + n0 + 4 * nq));
#pragma unroll
        for (int i = 0; i < 8; ++i) { LAS float* d = scr + (8 * i + kr) * 33 + 4 * nq; d[0] = v[i].x; d[1] = v[i].y; d[2] = v[i].z; d[3] = v[i].w; } }
    LDS_WAIT(); asm volatile("" ::: "memory");
    const int c = lane & 7;
#pragma unroll
    for (int j = 0; j < 4; ++j) { const int n = (lane >> 3) + 8 * j; const LAS float* s = scr + (8 * c) * 33 + n;
        const float sc = (nscale ? nscale[n] : 1.f) * cscale;
        v4u o; o.x = pk2(s[0 * 33] * sc, s[1 * 33] * sc); o.y = pk2(s[2 * 33] * sc, s[3 * 33] * sc); o.z = pk2(s[4 * 33] * sc, s[5 * 33] * sc); o.w = pk2(s[6 * 33] * sc, s[7 * 33] * sc);
        *(GAS v4u*)(WT + (size_t)(drow0 + n) * ldk + k0 + 8 * c) = o; }
    LDS_WAIT(); asm volatile("" ::: "memory");
}
__device__ __forceinline__ void p0_transpose_item_f8(const float* W, int N, unsigned char* WT, int ldk, int k0, int n0, LAS float* scr, int lane, float sc) {
    { const int kr = lane >> 3, nq = lane & 7; f32x4 v[8];
#pragma unroll
        for (int i = 0; i < 8; ++i) v[i] = __builtin_nontemporal_load((const GAS f32x4*)(W + (size_t)(k0 + 8 * i + kr) * N + n0 + 4 * nq));
#pragma unroll
        for (int i = 0; i < 8; ++i) { LAS float* d = scr + (8 * i + kr) * 33 + 4 * nq; d[0] = v[i].x; d[1] = v[i].y; d[2] = v[i].z; d[3] = v[i].w; } }
    LDS_WAIT(); asm volatile("" ::: "memory");
    const int c = lane & 7;
#pragma unroll
    for (int j = 0; j < 4; ++j) { const int n = (lane >> 3) + 8 * j; const LAS float* s = scr + (8 * c) * 33 + n;
        int w0 = __builtin_amdgcn_cvt_pk_fp8_f32(s[0 * 33] * sc, s[1 * 33] * sc, 0, false); w0 = __builtin_amdgcn_cvt_pk_fp8_f32(s[2 * 33] * sc, s[3 * 33] * sc, w0, true);
        int w1 = __builtin_amdgcn_cvt_pk_fp8_f32(s[4 * 33] * sc, s[5 * 33] * sc, 0, false); w1 = __builtin_amdgcn_cvt_pk_fp8_f32(s[6 * 33] * sc, s[7 * 33] * sc, w1, true);
        *(GAS v2u*)(WT + (size_t)(n0 + n) * ldk + k0 + 8 * c) = (v2u){(unsigned)w0, (unsigned)w1}; }
    LDS_WAIT(); asm volatile("" ::: "memory");
}
__device__ __forceinline__ void p0_transposes(Frame& F, int part, int wg, int nwg) {
    LAS float* scr = (LAS float*)(F.lds + RING_OFF + F.wave * 16384);
    const int gw = wg * NWAVES + F.wave, NGW = nwg * NWAVES;
    constexpr int I_IN = (D / 64) * (5152 / 32), I_OUT = (D / 64) * (D / 32), I_1 = (D / 64) * (FF / 32), I_2 = (FF / 64) * (D / 32), I_P = 4 * (256 / 64) * (256 / 32);
    if (part == 0) {
        constexpr int NB = 4128 / 32, I_INQ = (D / 64) * NB, I_WU = D;
        for (int it = gw; it < I_INQ + I_P + I_WU; it += NGW) { int r = it;
            if (r < I_INQ) { const int kb = r / NB, nb = r % NB, n0 = 32 * nb; const int dr = n0 < 4096 ? n0 : 5120;
                p0_transpose_item(F_w_in, 5152, F_WinT, D, 64 * kb, n0, dr, scr, F.lane, nullptr, n0 < 1024 ? 0.08838834764831845f : 1.f); continue; } r -= I_INQ;
            if (r < I_P) { const int g = r / 32, q = r % 32, kb = q / 8, nb = q % 8; p0_transpose_item(F_pool_w + (size_t)g * 65536, 256, F_PoolWT, 256, 64 * kb, 32 * nb, g * 256 + 32 * nb, scr, F.lane, F_pool_scale + g * 256 + 32 * nb); continue; } r -= I_P;
            { const GAS f32x4* s = (const GAS f32x4*)(F_w_in + (size_t)r * 5152 + 4128) + 4 * F.lane; const f32x4 a = s[0], b = s[1], c = s[2], d = s[3];
              GAS v4u* o = (GAS v4u*)(F_WU + (size_t)r * 1024) + 2 * F.lane; o[0] = (v4u){pk2(a.x, a.y), pk2(a.z, a.w), pk2(b.x, b.y), pk2(b.z, b.w)}; o[1] = (v4u){pk2(c.x, c.y), pk2(c.z, c.w), pk2(d.x, d.y), pk2(d.z, d.w)}; } }
        return;
    }
    constexpr int NITEMS = I_OUT + I_1 + I_2;
    for (int it = gw; it < NITEMS; it += NGW) {
        int r = it;
        if (r < I_OUT) { const int nblk = D / 32, kb = r / nblk, nb = r % nblk; p0_transpose_item_f8(F_w_out, D, (unsigned char*)F_WoutT, D, 64 * kb, 32 * nb, scr, F.lane, 64.f); continue; } r -= I_OUT;
        if (r < I_1) { const int nblk = FF / 32, kb = r / nblk, nb = r % nblk; p0_transpose_item_f8(F_w1, FF, (unsigned char*)F_W1T, D, 64 * kb, 32 * nb, scr, F.lane, W1_SCALE); continue; } r -= I_1;
        { const int nblk = D / 32, kb = r / nblk, nb = r % nblk; p0_transpose_item_f8(F_w2, D, (unsigned char*)F_W2T, FF, 64 * kb, 32 * nb, scr, F.lane, 64.f); }
    }
}
__device__ __forceinline__ void p0_mod_gemv(Frame& F) {
    LAS float* sil = (LAS float*)(F.lds);
    LAS float* red = (LAS float*)(F.lds + 73728);
    bool have = false;
    for (int item = F.vcu; item < 192; item += F.G) {
        if (!have) {
            { float cv[4][NMOD];
#pragma unroll
                for (int j = 0; j < 4; ++j) { const int k = F.tid + 512 * j; cv[j][0] = F_cctx[k];
#pragma unroll
                    for (int r = 1; r < NMOD; ++r) cv[j][r] = F_cc[(size_t)(r - 1) * D + k]; }
#pragma unroll
                for (int j = 0; j < 4; ++j) { const int k = F.tid + 512 * j;
#pragma unroll
                    for (int r = 0; r < NMOD; ++r) { const float c = cv[j][r]; sil[k * NMOD + r] = c / (1.f + __expf(-c)); } } }
            have = true;
        }
        __syncthreads();
        const int n0 = item * 64, kq = F.tid >> 4, c4 = F.tid & 15;
        float acc[NMOD][4];
#pragma unroll
        for (int r = 0; r < NMOD; ++r) { acc[r][0] = 0.f; acc[r][1] = 0.f; acc[r][2] = 0.f; acc[r][3] = 0.f; }
        const GAS f32x4* wp = (const GAS f32x4*)(F_ada_w + n0) + c4;
        for (int ib = 0; ib < 64; ib += 16) {
            f32x4 wv[16];
#pragma unroll
            for (int j = 0; j < 16; ++j) wv[j] = wp[(size_t)(kq + 32 * (ib + j)) * (12288 / 4)];
#pragma unroll
            for (int j = 0; j < 16; ++j) { const int k = kq + 32 * (ib + j); const f32x4 w = wv[j];
                if ((j & 3) == 0) __builtin_amdgcn_sched_barrier(0);
#pragma unroll
                for (int r = 0; r < NMOD; ++r) { const float s = sil[k * NMOD + r]; acc[r][0] += s * w.x; acc[r][1] += s * w.y; acc[r][2] += s * w.z; acc[r][3] += s * w.w; } } }
#pragma unroll
        for (int r = 0; r < NMOD; ++r)
#pragma unroll
            for (int j = 0; j < 4; ++j) { float v = acc[r][j]; v += __shfl_xor(v, 16); v += __shfl_xor(v, 32); acc[r][j] = v; }
        if (F.lane < 16) {
#pragma unroll
            for (int r = 0; r < NMOD; ++r)
#pragma unroll
                for (int j = 0; j < 4; ++j) red[(F.wave * NMOD + r) * 64 + 4 * c4 + j] = acc[r][j];
        }
        __syncthreads();
        for (int o = F.tid; o < NMOD * 64; o += NWAVES * 64) { const int r = o / 64, c = o % 64; float s = F_ada_b[n0 + c];
#pragma unroll
            for (int w = 0; w < 8; ++w) s += red[(w * NMOD + r) * 64 + c];
            F_MOD[(size_t)r * 12288 + n0 + c] = s; }
    }
    __syncthreads();
}
struct RowSeg { int lo, hi, mr; };
__device__ __forceinline__ bool next_seg(int& cur, int r_hi, RowSeg& s) {
    if (cur >= r_hi) return false;
    s.lo = cur; s.mr = modrow(cur); const int bound = s.mr == 0 ? NCTX : NCTX + s.mr * 2048; s.hi = bound < r_hi ? bound : r_hi; cur = s.hi; return true;
}
__device__ __forceinline__ void p1_h1(Frame& F) {
    const int lane = fresh_lane();
    const int bx = blockIdx.x; int r_lo, r_hi;
    if (F.G == 256) { r_lo = bx < 32 ? 66 * bx : 2112 + 82 * (bx - 32); r_hi = r_lo + (bx < 32 ? 66 : 82); } else { const int rp = (NTOK + F.G - 1) / F.G; r_lo = min(NTOK, bx * rp); r_hi = min(NTOK, r_lo + rp); }
    for (int u = bx; u < 32; u += F.G) {
        pg8::Gemm gm{F_PoolWT, F_WU, 256, 256, 1024, 0x7F7F7F7Fu};
        pg8::OneUnit S{{u >> 3, u & 7, 0, 256 * (u >> 3)}};
        pg8::EpiBf16<0, false> E{F_WinT + (size_t)4096 * D, D, nullptr, 0, 1.f};
        pg8::gemm_phase<pg8::EpiBf16<0, false>, pg8::OneUnit, false, true>(F.lds + RING_OFF, gm, S, E);
    }
    LAS f32x4* pA = (LAS f32x4*)(F.lds); LAS f32x4* pC = pA + D / 4;
    int cur = r_lo; RowSeg sg;
    while (next_seg(cur, r_hi, sg)) {
        const float* mod = F_MOD + (size_t)sg.mr * 12288;
        for (int i = F.tid; i < D / 4; i += NWAVES * 64) { const f32x4 w = *(const f32x4*)(F_norm_w + 4 * i), sc = *(const f32x4*)(mod + 2048 + 4 * i); pA[i] = w * (sc + 1.f); pC[i] = *(const f32x4*)(mod + 4 * i); }
        __syncthreads();
        for (int m = sg.lo + F.wave; m < sg.hi; m += NWAVES) {
            const GAS f32x4* xr = (const GAS f32x4*)xrow_ptr(F, m) + lane;
            f32x4 v[8]; float s = 0.f;
#pragma unroll
            for (int j = 0; j < 8; ++j) { v[j] = xr[64 * j]; s += (v[j].x * v[j].x + v[j].y * v[j].y) + (v[j].z * v[j].z + v[j].w * v[j].w); }
            const float rstd = rsqrtf(wave_sum(s) * (1.f / D) + EPS);
            GAS v2u* o8 = (GAS v2u*)(F_RB + (size_t)m * D) + lane;
#pragma unroll
            for (int j = 0; j < 8; ++j) { const f32x4 h = v[j] * rstd * pA[lane + 64 * j] + pC[lane + 64 * j];
                v2u o; o.x = pk2(h.x, h.y); o.y = pk2(h.z, h.w); o8[64 * j] = o; }
        }
        __syncthreads();
    }
}
typedef short s16x4 __attribute__((ext_vector_type(4)));
__device__ __forceinline__ bf16x8 tr_pair(const LAS bf16* p, int ld) {
    const s16x4 a = __builtin_amdgcn_ds_read_tr16_b64_v4i16((LAS s16x4*)p);
    const s16x4 b = __builtin_amdgcn_ds_read_tr16_b64_v4i16((LAS s16x4*)(p + 16 * ld));
    return (bf16x8){a[0], a[1], a[2], a[3], b[0], b[1], b[2], b[3]};
}
struct GatePre { float gi0, gi1, gf0, gf1; };
__device__ __forceinline__ GatePre gate_load(const float* GATES, int seqbase, int T, int dir, int c, int lane, int gi_col, int gf_col) {
    typedef float f32x2_t __attribute__((ext_vector_type(2)));
    const int j0 = c * 128 + 2 * lane, lo = dir ? T - 2 - j0 : j0;
    const f32x2_t vi = *(const GAS f32x2_t*)(GATES + (size_t)gi_col * NTOK + seqbase + lo), vf = *(const GAS f32x2_t*)(GATES + (size_t)gf_col * NTOK + seqbase + lo);
    GatePre g; g.gi0 = dir ? vi.y : vi.x; g.gi1 = dir ? vi.x : vi.y; g.gf0 = dir ? vf.y : vf.x; g.gf1 = dir ? vf.x : vf.y; return g;
}
__device__ __forceinline__ float logsig(float x) { return fminf(x, 0.f) - log1pf(__expf(-fabsf(x))); }
__device__ __forceinline__ float gate_finish(const GatePre g, float bias_i, float bias_f, float mchunk, LAS float* gb, LAS float* sc, int lane) {
    const float li0 = g.gi0 + bias_i, li1 = g.gi1 + bias_i, lf0 = logsig(g.gf0 + bias_f), lf1 = logsig(g.gf1 + bias_f);
    const float c1 = lf0 + lf1; float incl = c1;
#pragma unroll
    for (int o = 1; o < 64; o <<= 1) { const float v = __shfl_up(incl, o); if (lane >= o) incl += v; }
    const float excl = incl - c1, b0 = excl + lf0, b1 = incl;
    const float a0 = li0 - b0, a1 = li1 - b1, p1 = fmaxf(a0, a1); float im = p1;
#pragma unroll
    for (int o = 1; o < 64; o <<= 1) { const float v = __shfl_up(im, o); if (lane >= o) im = fmaxf(im, v); }
    float em = __shfl_up(im, 1); if (lane == 0) em = -INFINITY;
    const float M0 = fmaxf(mchunk, fmaxf(em, a0)), M1 = fmaxf(mchunk, im);
    const float Mlast = __shfl(M1, 63), blast = __shfl(b1, 63);
    typedef float f32x2 __attribute__((ext_vector_type(2)));
    *(LAS f32x2*)(gb + 2 * lane) = (f32x2){a0 * 1.44269504089f, a1 * 1.44269504089f};
    *(LAS f32x2*)(gb + 128 + 2 * lane) = (f32x2){M0, M1};
    *(LAS f32x2*)(gb + 256 + 2 * lane) = (f32x2){b0 + M0, b1 + M1};
    *(LAS f32x2*)(gb + 384 + 2 * lane) = (f32x2){__expf(a0 - Mlast), __expf(a1 - Mlast)};
    const float mnext = blast + Mlast;
    if (lane == 0) { sc[0] = mchunk; sc[1] = mnext; }
    return mnext;
}
#define ML_EP(i, j) (32 * ((i) >> 1) + 8 * ((j) >> 2) + 4 * ((i) & 1) + ((j) & 3))
template <int TT> __device__ __forceinline__ void mlstm_unit(Frame& F, int path, int b, int h, int dir, int eh) {
    const int T = path ? 2048 : 256, nc = T / 128, seqbase = path ? NCTX + b * 2048 : b * 256;
    constexpr int w = TT < 4 ? TT : 11 - TT, tt = TT;
    const int lane = fresh_lane(), tid = w * 64 + lane, lr = lane & 15, lq = lane >> 4, q4 = lr >> 2, p4 = lr & 3;
    const int sidx = ((b * 2 + dir) * NH + h);
    const float* GATES = F_GATES; const bf16* PROJ = F_PROJ;
    f32x4 accC[5];
#pragma unroll
    for (int i = 0; i < 5; ++i) accC[i] = (f32x4){0.f, 0.f, 0.f, 0.f};
    float m0 = 0.f;
    if (path) {
        const float* C0 = F_stC + (size_t)sidx * DH * DH;
#pragma unroll
        for (int i = 0; i < 4; ++i)
#pragma unroll
            for (int r = 0; r < 4; ++r) accC[i][r] = C0[(size_t)(16 * w + 4 * lq + r) * DH + 64 * eh + ML_EP(i, lr)];
        if (lr == 0) {
#pragma unroll
            for (int r = 0; r < 4; ++r) accC[4][r] = F_stN[(size_t)sidx * DH + 16 * w + 4 * lq + r]; }
        m0 = F_stM[sidx];
    }
    const int gi_col = (dir ? 16 : 0) + h, gf_col = (dir ? 24 : 8) + h;
    const float bias_i = F_gate_bias[gi_col], bias_f = F_gate_bias[gf_col];
    float mchain = m0;
    if (w == 0) { const GatePre g = gate_load(GATES, seqbase, T, dir, 0, lane, gi_col, gf_col);
        mchain = gate_finish(g, bias_i, bias_f, mchain, (LAS float*)(F.lds + ML_G), (LAS float*)(F.lds + ML_SC), lane); }
    { LAS bf16* CT = (LAS bf16*)(F.lds + ML_CT);
#pragma unroll
        for (int i = 0; i < 5; ++i) if (i < 4 || lr == 0) { v2u o; o.x = pk2(accC[i][0], accC[i][1]); o.y = pk2(accC[i][2], accC[i][3]); *(LAS v2u*)(CT + (16 * i + lr) * KLD + 16 * w + 4 * lq) = o; } }
    constexpr bool LDR = (w < 4); constexpr int NKL = LDR ? 8 : 0, NVL = LDR ? 4 : 0;
    const int krow = (tid & 255) >> 4, kch = tid & 15, vrow = (tid & 255) >> 3, vch = tid & 7;
    v4u kv[8], vv[4]; bf16x8 bq[4], bqn[4]; v4u hold[2];
#pragma unroll
    for (int i = 0; i < 4; ++i) { bqn[i] = (bf16x8){0, 0, 0, 0, 0, 0, 0, 0}; hold[i >> 1] = (v4u){0u, 0u, 0u, 0u}; }
    {
#pragma unroll
        for (int i = 0; i < NKL; ++i) { const int s = krow + 16 * i, stok = dir ? T - 1 - s : s; kv[i] = *(const GAS v4u*)(PROJ + (size_t)(seqbase + stok) * PROJ_LD + 1024 + h * DH + kch * 8); }
#pragma unroll
        for (int i = 0; i < NVL; ++i) { const int s = vrow + 32 * i, stok = dir ? T - 1 - s : s; vv[i] = *(const GAS v4u*)(PROJ + (size_t)(seqbase + stok) * PROJ_LD + 2048 + h * DH + 64 * eh + vch * 8); }
        const int qtok = dir ? T - 1 - (16 * tt + lr) : 16 * tt + lr; const bf16* qrow = PROJ + (size_t)(seqbase + qtok) * PROJ_LD + h * DH + 8 * lq;
#pragma unroll
        for (int kk = 0; kk < 4; ++kk) bq[kk] = *(const GAS bf16x8*)(qrow + 32 * kk); }
    if constexpr (LDR) asm volatile("" :: "v"(kv[0]), "v"(kv[1]), "v"(kv[2]), "v"(kv[3]), "v"(kv[4]), "v"(kv[5]), "v"(kv[6]), "v"(kv[7]), "v"(vv[0]), "v"(vv[1]), "v"(vv[2]), "v"(vv[3]));
    asm volatile("" :: "v"(bq[0]), "v"(bq[1]), "v"(bq[2]), "v"(bq[3]));
    const bf16x8 ones = (lr == 0) ? (bf16x8){0x3F80, 0x3F80, 0x3F80, 0x3F80, 0x3F80, 0x3F80, 0x3F80, 0x3F80} : (bf16x8){0, 0, 0, 0, 0, 0, 0, 0};
    for (int c = 0; c < nc; ++c) {
        const int buf = c & 1;
        LAS bf16* Kb = (LAS bf16*)(F.lds + ML_KB + buf * ML_KB_SZ); LAS bf16* Vb = (LAS bf16*)(F.lds + ML_VB + buf * ML_VB_SZ);
        const LAS bf16* CTb = (const LAS bf16*)(F.lds + ML_CT + buf * ML_CT_SZ);
        const LAS float* gb = (const LAS float*)(F.lds + ML_G + buf * ML_G_SZ); const LAS float* sc = (const LAS float*)(F.lds + ML_SC + buf * 16);
#pragma unroll
        for (int i = 0; i < NKL; ++i) *(LAS v4u*)(Kb + (krow + 16 * i) * KLD + kch * 8) = kv[i];
#pragma unroll
        for (int i = 0; i < NVL; ++i) { LAS bf16* vd = Vb + (vrow + 32 * i) * VLD + 32 * (vch >> 2) + 4 * (vch & 3);
            *(LAS v2u*)vd = (v2u){vv[i].x, vv[i].y}; *(LAS v2u*)(vd + 16) = (v2u){vv[i].z, vv[i].w}; }
        __syncthreads();
        const bool more = (c + 1 < nc);
        const int t = 16 * tt + lr;
        const int cn = more ? c + 1 : c, cp = c > 0 ? c - 1 : 0;
        GatePre gpre; gpre.gi0 = 0.f; gpre.gi1 = 0.f; gpre.gf0 = 0.f; gpre.gf1 = 0.f;
        if (w == 0) gpre = gate_load(GATES, seqbase, T, dir, cn, lane, gi_col, gf_col);
#define ML_VM_ST do { const int tok = dir ? T - 1 - (cp * 128 + t) : cp * 128 + t; bf16* hp = F_HDIR + ((size_t)dir * NTOK + seqbase + tok) * MW + h * DH + 64 * eh + 8 * lq; \
            *(GAS v4u*)hp = hold[0]; *(GAS v4u*)(hp + 32) = hold[1]; } while (0)
#define ML_VM_K(i0) do { if constexpr (LDR) { _Pragma("unroll") for (int i = (i0); i < (i0) + 2; ++i) { const int s = cn * 128 + krow + 16 * i, stok = dir ? T - 1 - s : s; \
            kv[i] = *(const GAS v4u*)(PROJ + (size_t)(seqbase + stok) * PROJ_LD + 1024 + h * DH + kch * 8); } } } while (0)
#define ML_VM_V(i0) do { if constexpr (LDR) { _Pragma("unroll") for (int i = (i0); i < (i0) + 2; ++i) { const int s = cn * 128 + vrow + 32 * i, stok = dir ? T - 1 - s : s; \
            vv[i] = *(const GAS v4u*)(PROJ + (size_t)(seqbase + stok) * PROJ_LD + 2048 + h * DH + 64 * eh + vch * 8); } } } while (0)
#define ML_VM_Q(k0) do { const int qtok = dir ? T - 1 - (cn * 128 + t) : cn * 128 + t; const bf16* qrow = PROJ + (size_t)(seqbase + qtok) * PROJ_LD + h * DH + 8 * lq; \
            _Pragma("unroll") for (int kk = (k0); kk < (k0) + 2; ++kk) bqn[kk] = *(const GAS bf16x8*)(qrow + 32 * kk); } while (0)
        const float Mt = gb[128 + t], mt = gb[256 + t], Mlast = gb[128 + 127], mcur = sc[0];
#define ML_SB __builtin_amdgcn_sched_barrier(0)
#define ML_LOADK(dst, kk) do { _Pragma("unroll") for (int si = 0; si < 8; ++si) if (si <= tt) dst[si] = *(const LAS bf16x8*)(Kb + (16 * si + lr) * KLD + 32 * (kk) + 8 * lq); } while (0)
#define ML_MMAK(src, kk) do { _Pragma("unroll") for (int si = 0; si < 8; ++si) if (si <= tt) st[si] = __builtin_amdgcn_mfma_f32_16x16x32_bf16(src[si], bq[kk], st[si], 0, 0, 0); } while (0)
#define ML_LOADC(dst, kk) do { _Pragma("unroll") for (int i = 0; i < 5; ++i) dst[i] = *(const LAS bf16x8*)(CTb + (16 * i + lr) * KLD + 32 * (kk) + 8 * lq); } while (0)
#define ML_MMAC(src, kk) do { _Pragma("unroll") for (int i = 0; i < 5; ++i) nm[i] = __builtin_amdgcn_mfma_f32_16x16x32_bf16(src[i], bq[kk], nm[i], 0, 0, 0); } while (0)
#define ML_LOADV(vf, ak, wa, wb, kk) do { _Pragma("unroll") for (int i = 0; i < 4; ++i) vf[i] = tr_pair(Vb + (32 * (kk) + 4 * lq + q4) * VLD + 16 * i + 4 * p4, VLD); \
            ak = tr_pair(Kb + (32 * (kk) + 4 * lq + q4) * KLD + 16 * w + 4 * p4, KLD); \
            wa = *(const LAS f32x4*)(gb + 384 + 32 * (kk) + 4 * lq); wb = *(const LAS f32x4*)(gb + 384 + 32 * (kk) + 16 + 4 * lq); } while (0)
#define ML_KSTEP(vf, ak, wa, wb, kk) do { \
            if (2 * (kk) <= tt) { \
                _Pragma("unroll") for (int i = 0; i < 4; ++i) nm[i] = __builtin_amdgcn_mfma_f32_16x16x32_bf16(vf[i], bp[kk], nm[i], 0, 0, 0); \
                nm[4] = __builtin_amdgcn_mfma_f32_16x16x32_bf16(ones, bp[kk], nm[4], 0, 0, 0); } \
            const v4u ar = __builtin_bit_cast(v4u, ak); \
            const v4u aw = (v4u){pk2(bflo(ar[0]) * wa[0], bfhi(ar[0]) * wa[1]), pk2(bflo(ar[1]) * wa[2], bfhi(ar[1]) * wa[3]), pk2(bflo(ar[2]) * wb[0], bfhi(ar[2]) * wb[1]), pk2(bflo(ar[3]) * wb[2], bfhi(ar[3]) * wb[3])}; \
            const bf16x8 akw = __builtin_bit_cast(bf16x8, aw); \
            _Pragma("unroll") for (int i = 0; i < 4; ++i) accC[i] = __builtin_amdgcn_mfma_f32_16x16x32_bf16(akw, vf[i], accC[i], 0, 0, 0); \
            accC[4] = __builtin_amdgcn_mfma_f32_16x16x32_bf16(akw, ones, accC[4], 0, 0, 0); } while (0)
        f32x4 st[8], nm[5];
#pragma unroll
        for (int si = 0; si < 8; ++si) st[si] = (f32x4){0.f, 0.f, 0.f, 0.f};
#pragma unroll
        for (int i = 0; i < 5; ++i) nm[i] = (f32x4){0.f, 0.f, 0.f, 0.f};
        bf16x8 va[4], vb[4], aka, akb; f32x4 waa, wba, wab, wbb; f32x4 av[8];
        {
            bf16x8 fa[8], fb[8];
            ML_LOADK(fa, 0); ML_SB; ML_LOADK(fb, 1); ML_SB; ML_MMAK(fa, 0); ML_VM_K(0); ML_SB; ML_LOADK(fa, 2); ML_SB; ML_MMAK(fb, 1); ML_VM_K(2); ML_SB; ML_LOADK(fb, 3); ML_SB; ML_MMAK(fa, 2); ML_VM_K(4); ML_SB;
            ML_LOADC(fa, 0); ML_SB; ML_MMAK(fb, 3); ML_VM_K(6); ML_SB; ML_LOADC(fb, 1); ML_SB; ML_MMAC(fa, 0); ML_VM_V(0); ML_VM_Q(0); ML_SB; ML_LOADC(fa, 2); ML_SB; ML_MMAC(fb, 1); ML_VM_V(2); ML_VM_Q(2); ML_SB; ML_LOADC(fb, 3); ML_SB; ML_MMAC(fa, 2); ML_VM_ST; ML_SB;
            ML_LOADV(va, aka, waa, wba, 0);
#pragma unroll
            for (int si = 0; si < 8; ++si) if (si <= tt) av[si] = *(const LAS f32x4*)(gb + 16 * si + 4 * lq);
            ML_SB; ML_MMAC(fb, 3); ML_SB;
        }
        const float gt = __expf(mcur - Mt), gs = __expf(mcur - Mlast);
#pragma unroll
        for (int i = 0; i < 5; ++i) { nm[i] = nm[i] * gt; accC[i] = accC[i] * gs; }
        const float Mt2 = Mt * 1.44269504089f;
#pragma unroll
        for (int si = 0; si < 8; ++si) if (si <= tt) {
#pragma unroll
            for (int r = 0; r < 4; ++r) { const float p = st[si][r] * __builtin_amdgcn_exp2f(av[si][r] - Mt2); st[si][r] = (si < tt || 4 * lq + r <= lr) ? p : 0.f; } }
        bf16x8 bp[4];
#pragma unroll
        for (int kk = 0; kk < 4; ++kk) { const v4u pw = (v4u){pk2(st[2 * kk][0], st[2 * kk][1]), pk2(st[2 * kk][2], st[2 * kk][3]), pk2(st[2 * kk + 1][0], st[2 * kk + 1][1]), pk2(st[2 * kk + 1][2], st[2 * kk + 1][3])};
            bp[kk] = __builtin_bit_cast(bf16x8, pw); }
        ML_SB; ML_LOADV(vb, akb, wab, wbb, 1); ML_SB; ML_KSTEP(va, aka, waa, wba, 0); ML_SB;
        ML_LOADV(va, aka, waa, wba, 2); ML_SB; ML_KSTEP(vb, akb, wab, wbb, 1); ML_SB;
        ML_LOADV(vb, akb, wab, wbb, 3); ML_SB; ML_KSTEP(va, aka, waa, wba, 2); ML_SB;
        ML_KSTEP(vb, akb, wab, wbb, 3); ML_SB;
#undef ML_SB
#undef ML_VM_ST
#undef ML_VM_K
#undef ML_VM_V
#undef ML_VM_Q
#undef ML_LOADK
#undef ML_MMAK
#undef ML_LOADC
#undef ML_MMAC
#undef ML_LOADV
#undef ML_KSTEP
        const float den = __shfl(nm[4][0], lr);
        const float inv = 1.f / fmaxf(fabsf(den), __expf(-mt));
#pragma unroll
        for (int a = 0; a < 2; ++a) hold[a] = (v4u){pk2(nm[2 * a][0] * inv, nm[2 * a][1] * inv), pk2(nm[2 * a][2] * inv, nm[2 * a][3] * inv), pk2(nm[2 * a + 1][0] * inv, nm[2 * a + 1][1] * inv), pk2(nm[2 * a + 1][2] * inv, nm[2 * a + 1][3] * inv)};
        { LAS bf16* CTn = (LAS bf16*)(F.lds + ML_CT + (buf ^ 1) * ML_CT_SZ);
#pragma unroll
            for (int i = 0; i < 5; ++i) if (i < 4 || lr == 0) { v2u o; o.x = pk2(accC[i][0], accC[i][1]); o.y = pk2(accC[i][2], accC[i][3]); *(LAS v2u*)(CTn + (16 * i + lr) * KLD + 16 * w + 4 * lq) = o; } }
        if (more && w == 0) mchain = gate_finish(gpre, bias_i, bias_f, mchain, (LAS float*)(F.lds + ML_G + (buf ^ 1) * ML_G_SZ), (LAS float*)(F.lds + ML_SC + (buf ^ 1) * 16), lane);
#pragma unroll
        for (int kk = 0; kk < 4; ++kk) bq[kk] = bqn[kk];
    }
    { const int t = 16 * tt + lr, tok = dir ? T - 1 - ((nc - 1) * 128 + t) : (nc - 1) * 128 + t;
        bf16* hp = F_HDIR + ((size_t)dir * NTOK + seqbase + tok) * MW + h * DH + 64 * eh + 8 * lq;
        *(GAS v4u*)hp = hold[0]; *(GAS v4u*)(hp + 32) = hold[1]; }
    if (!path) {
        const int l2 = fresh_lane(), lr2 = l2 & 15, lq2 = l2 >> 4;
        float* oC = F_out + (size_t)NTOK * D + (size_t)sidx * DH * DH;
#pragma unroll
        for (int i = 0; i < 4; ++i)
#pragma unroll
            for (int r = 0; r < 4; ++r) oC[(size_t)(16 * w + 4 * lq2 + r) * DH + 64 * eh + ML_EP(i, lr2)] = accC[i][r];
        if (eh == 0) {
            float* oN = F_out + (size_t)NTOK * D + (size_t)16 * 2 * NH * DH * DH + (size_t)sidx * DH;
            if (lr2 == 0) {
#pragma unroll
                for (int r = 0; r < 4; ++r) oN[16 * w + 4 * lq2 + r] = accC[4][r]; }
            if (w == 0 && l2 == 0) F_out[(size_t)NTOK * D + (size_t)16 * 2 * NH * DH * DH + (size_t)16 * 2 * NH * DH + sidx] = mchain;
        }
    }
    __syncthreads();
}
__device__ __forceinline__ void p3_mlstm(Frame& F) {
    for (int u = F.vcu; u < 768; u += F.G) {
        const int path = u < 256 ? 1 : 0, id = path ? u : u - 256, b = id >> 5, h = (id >> 2) & 7, dir = (id >> 1) & 1, eh = id & 1;
        switch (F.wave) {
            case 0: mlstm_unit<0>(F, path, b, h, dir, eh); break;
            case 1: mlstm_unit<1>(F, path, b, h, dir, eh); break;
            case 2: mlstm_unit<2>(F, path, b, h, dir, eh); break;
            case 3: mlstm_unit<3>(F, path, b, h, dir, eh); break;
            case 4: mlstm_unit<7>(F, path, b, h, dir, eh); break;
            case 5: mlstm_unit<6>(F, path, b, h, dir, eh); break;
            case 6: mlstm_unit<5>(F, path, b, h, dir, eh); break;
            default: mlstm_unit<4>(F, path, b, h, dir, eh); break;
        }
    }
}
constexpr float HMIX_SCALE = 16.f;
__device__ __forceinline__ void p4_combine(Frame& F) {
    const int lane = fresh_lane();
    const int c0 = 16 * lane;
    const int bx = blockIdx.x; int r_lo, r_hi;
    if (F.G == 256) { r_lo = bx < 64 ? 74 * bx : 4736 + 82 * (bx - 64); r_hi = r_lo + (bx < 64 ? 74 : 82); } else { const int rp = (NTOK + F.G - 1) / F.G; r_lo = min(NTOK, bx * rp); r_hi = min(NTOK, r_lo + rp); }
    for (int m = r_lo + F.wave; m < r_hi; m += NWAVES) {
        const GAS v4u* pf = (const GAS v4u*)(F_HDIR + (size_t)m * MW + c0);
        const GAS v4u* pb = (const GAS v4u*)(F_HDIR + ((size_t)NTOK + m) * MW + c0);
        const GAS v4u* po = (const GAS v4u*)(F_PROJ + (size_t)m * PROJ_LD + 3072 + c0);
        float hv[16], ov[16]; float ss = 0.f;
#pragma unroll
        for (int i = 0; i < 2; ++i) { const v4u a = pf[i], bb = pb[i], o = po[i];
#pragma unroll
            for (int j = 0; j < 4; ++j) { const float x0 = bflo(a[j]) + bflo(bb[j]), x1 = bfhi(a[j]) + bfhi(bb[j]); hv[8 * i + 2 * j] = x0; hv[8 * i + 2 * j + 1] = x1; ss += x0 * x0 + x1 * x1;
                ov[8 * i + 2 * j] = bflo(o[j]); ov[8 * i + 2 * j + 1] = bfhi(o[j]); } }
        ss += __shfl_xor(ss, 1); ss += __shfl_xor(ss, 2); ss += __shfl_xor(ss, 4);
        const float rstd = rsqrtf(ss * (1.f / DH) + EPS);
        float yv[16];
#pragma unroll
        for (int j = 0; j < 16; ++j) { const float y = hv[j] * rstd * F_mnw[c0 + j] / (1.f + __expf(-ov[j])) * HMIX_SCALE; yv[j] = fminf(fmaxf(y, -448.f), 448.f); }
        int ow[4];
#pragma unroll
        for (int j = 0; j < 4; ++j) { const int w = __builtin_amdgcn_cvt_pk_fp8_f32(yv[4 * j], yv[4 * j + 1], 0, false); ow[j] = __builtin_amdgcn_cvt_pk_fp8_f32(yv[4 * j + 2], yv[4 * j + 3], w, true); }
        *(GAS v4u*)((unsigned char*)F_RB + (size_t)m * D + c0) = (v4u){(unsigned)ow[0], (unsigned)ow[1], (unsigned)ow[2], (unsigned)ow[3]};
    }
}
template <int WIN> __device__ __forceinline__ void pool_rows(const bf16* ub, unsigned char* pb, int ldo, int rbase, int L) {
    constexpr int HALFW = WIN / 2, NR = 16 + WIN;
#pragma unroll 1
    for (int rb = 0; rb < 4; ++rb) {
        const int r0 = rbase + 16 * rb, seg0 = (r0 / L) * L, tp0 = r0 - seg0;
        unsigned x[NR];
#pragma unroll
        for (int i = 0; i < NR; ++i) { const int tp = tp0 - HALFW + i; const int tc = min(max(tp, 0), L - 1); x[i] = *(const GAS unsigned*)(ub + (size_t)(seg0 + tc) * PROJ_LD); }
        float s0 = 0.f, s1 = 0.f;
#pragma unroll
        for (int q = 0; q < WIN; ++q) { const int tq = tp0 - HALFW + q; const float ok = (tq >= 0 && tq < L) ? 1.f : 0.f; s0 += ok * bflo(x[q]); s1 += ok * bfhi(x[q]); }
#pragma unroll
        for (int i = 0; i < 16; ++i) { const int tp = tp0 + i;
            if (i > 0) { const int te = tp + HALFW - 1, tl = tp - HALFW - 1; const float oke = (te < L) ? 1.f : 0.f, okl = (tl >= 0) ? 1.f : 0.f;
                s0 += oke * bflo(x[i + WIN - 1]) - okl * bflo(x[i - 1]); s1 += oke * bfhi(x[i + WIN - 1]) - okl * bfhi(x[i - 1]); }
            const int lo = max(tp - HALFW, 0), hi = min(tp + HALFW, L); const float inv = 1.f / (float)(hi - lo);
            { const float y0 = (s0 * inv - bflo(x[i + HALFW])) * HMIX_SCALE, y1 = (s1 * inv - bfhi(x[i + HALFW])) * HMIX_SCALE;
              *(GAS unsigned short*)(pb + (size_t)(r0 + i) * ldo) = (unsigned short)__builtin_amdgcn_cvt_pk_fp8_f32(fminf(fmaxf(y0, -448.f), 448.f), fminf(fmaxf(y1, -448.f), 448.f), 0, false); } }
    }
}
__device__ __forceinline__ void p4_pool_unit(Frame& F, int pm, int g) {
    const int L = pm < 16 ? 256 : 64;
    const int rbase = (F.tid >> 7) * 64, ch = F.tid & 127;
    const bf16* ub = F_PROJ + (size_t)pm * 256 * PROJ_LD + 4096 + 256 * g + 2 * ch;
    unsigned char* pb = (unsigned char*)F_RB + (size_t)pm * 256 * D + 1024 + 256 * g + 2 * ch;
    if (g == 0) pool_rows<2>(ub, pb, D, rbase, L); else if (g == 1) pool_rows<4>(ub, pb, D, rbase, L); else if (g == 2) pool_rows<8>(ub, pb, D, rbase, L); else pool_rows<16>(ub, pb, D, rbase, L);
}
__device__ __forceinline__ f32x4 bf4(v2u w) { return (f32x4){bflo(w.x), bfhi(w.x), bflo(w.y), bfhi(w.y)}; }
__device__ __forceinline__ float sq4(f32x4 v) { return (v.x * v.x + v.y * v.y) + (v.z * v.z + v.w * v.w); }
__device__ __forceinline__ void p6_norm(Frame& F) {
    const int lane = fresh_lane();
    const bf16* MIX = F_HDIR; const bf16* MIX1 = F_MIX1;
    LAS f32x4* pA = (LAS f32x4*)(F.lds); LAS f32x4* pB = pA + D / 4; LAS f32x4* pC = pB + D / 4;
    const int rpw = (NTOK + F.G - 1) / F.G, r_lo = F.vcu * rpw, r_hi = min(NTOK, r_lo + rpw);
    int cur = r_lo; RowSeg sg;
    while (next_seg(cur, r_hi, sg)) {
        const float* mod = F_MOD + (size_t)sg.mr * 12288;
        for (int i = F.tid; i < D / 4; i += NWAVES * 64) { const f32x4 w1 = *(const f32x4*)(F_norm_w + D + 4 * i), ga = *(const f32x4*)(mod + 2 * D + 4 * i), w2 = *(const f32x4*)(F_norm_w + 2 * D + 4 * i), sc = *(const f32x4*)(mod + 4 * D + 4 * i);
            pA[i] = ga * w1; pB[i] = w2 * (sc + 1.f); pC[i] = *(const f32x4*)(mod + 3 * D + 4 * i); }
        __syncthreads();
        for (int m = sg.lo + F.wave; m < sg.hi; m += NWAVES) {
            f32x4 v[8]; v2u mm[8];
            { const GAS f32x4* xr = (const GAS f32x4*)xrow_ptr(F, m) + lane; const GAS v2u* mr = (const GAS v2u*)(MIX + (size_t)m * D) + lane;
#pragma unroll
                for (int j = 0; j < 8; ++j) { v[j] = __builtin_nontemporal_load(xr + 64 * j); mm[j] = __builtin_nontemporal_load(mr + 64 * j); } }
            f32x4 mx[8]; float sq = 0.f;
#pragma unroll
            for (int j = 0; j < 8; ++j) mx[j] = bf4(mm[j]);
            if (m >= TAIL_PM0 * 256) { const GAS v2u* m1 = (const GAS v2u*)(MIX1 + (size_t)(m - TAIL_PM0 * 256) * D) + lane;
#pragma unroll
                for (int j = 0; j < 8; ++j) mx[j] = mx[j] + bf4(m1[64 * j]); }
#pragma unroll
            for (int j = 0; j < 8; ++j) sq += sq4(mx[j]);
            const float rstd1 = rsqrtf(wave_sum(sq) * (1.f / D) + EPS);
            float s = 0.f;
#pragma unroll
            for (int j = 0; j < 8; ++j) { v[j] = v[j] + pA[lane + 64 * j] * (mx[j] * rstd1); s += sq4(v[j]); }
            const float rstd2 = rsqrtf(wave_sum(s) * (1.f / D) + EPS);
            GAS v2u* xrow = (GAS v2u*)(F_out + (size_t)m * D) + lane;
            GAS unsigned* o8 = (GAS unsigned*)((unsigned char*)F_RB + (size_t)m * D) + lane;
#pragma unroll
            for (int j = 0; j < 8; ++j) { v2u xo; xo.x = pk2(v[j].x, v[j].y); xo.y = pk2(v[j].z, v[j].w); xrow[64 * j] = xo;
                const f32x4 h = (v[j] * rstd2 * pB[lane + 64 * j] + pC[lane + 64 * j]) * H2_SCALE;
                int w = __builtin_amdgcn_cvt_pk_fp8_f32(fminf(fmaxf(h.x, -448.f), 448.f), fminf(fmaxf(h.y, -448.f), 448.f), 0, false);
                w = __builtin_amdgcn_cvt_pk_fp8_f32(fminf(fmaxf(h.z, -448.f), 448.f), fminf(fmaxf(h.w, -448.f), 448.f), w, true); o8[64 * j] = (unsigned)w; }
        }
        __syncthreads();
    }
}
__device__ __forceinline__ void p9_final(Frame& F) {
    const int lane = fresh_lane();
    const bf16* Y1 = F_Y1;
    LAS f32x4* pA = (LAS f32x4*)(F.lds);
    const int rpw = (NTOK + F.G - 1) / F.G, r_lo = F.vcu * rpw, r_hi = min(NTOK, r_lo + rpw);
    int cur = r_lo; RowSeg sg;
    while (next_seg(cur, r_hi, sg)) {
        const float* mod = F_MOD + (size_t)sg.mr * 12288;
        for (int i = F.tid; i < D / 4; i += NWAVES * 64) pA[i] = *(const f32x4*)(mod + 5 * D + 4 * i) * *(const f32x4*)(F_norm_w + 3 * D + 4 * i);
        __syncthreads();
        for (int mb = sg.lo + 2 * F.wave; mb < sg.hi; mb += 2 * NWAVES) {
            v2u xx[2][8]; v2u yy[2][8];
#pragma unroll
            for (int q = 0; q < 2; ++q) { const int m = min(mb + q, sg.hi - 1);
                const GAS v2u* xr = (const GAS v2u*)(F_out + (size_t)m * D) + lane; const GAS v2u* yr = (const GAS v2u*)(F_RB + (size_t)m * D) + lane;
#pragma unroll
                for (int j = 0; j < 8; ++j) { xx[q][j] = __builtin_nontemporal_load(xr + 64 * j); yy[q][j] = __builtin_nontemporal_load(yr + 64 * j); } }
#pragma unroll
            for (int q = 0; q < 2; ++q) { const int m = min(mb + q, sg.hi - 1);
                f32x4 yv[8]; float sq = 0.f;
#pragma unroll
                for (int j = 0; j < 8; ++j) yv[j] = bf4(yy[q][j]);
                if (m >= TAIL_PM0 * 256) { const GAS v2u* y1 = (const GAS v2u*)(Y1 + (size_t)(m - TAIL_PM0 * 256) * D) + lane;
#pragma unroll
                    for (int j = 0; j < 8; ++j) yv[j] = yv[j] + bf4(y1[64 * j]); }
#pragma unroll
                for (int j = 0; j < 8; ++j) sq += sq4(yv[j]);
                const float rstd = rsqrtf(wave_sum(sq) * (1.f / D) + EPS);
                if (mb + q < sg.hi) {
                    GAS f32x4* orow = (GAS f32x4*)(F_out + (size_t)m * D) + lane;
#pragma unroll
                    for (int j = 0; j < 8; ++j) orow[64 * j] = bf4(xx[q][j]) + pA[lane + 64 * j] * (yv[j] * rstd); } }
        }
        __syncthreads();
    }
}

__global__ void __launch_bounds__(NWAVES * 64, 2) hymba_fwd(Args args) {
    extern __shared__ __attribute__((aligned(16))) unsigned char lds[];
    Frame F;
    F.lds = (LAS unsigned char*)lds;
    F.MISC = (volatile LAS unsigned*)(F.lds + MISC_OFF);
    F.tid = threadIdx.x; F.lane = F.tid & 63; F.wave = __builtin_amdgcn_readfirstlane(F.tid >> 6);
    F.G = gridDim.x; { const int bx = blockIdx.x; F.vcu = (F.G % 8 == 0) ? (bx % 8) * (F.G / 8) + bx / 8 : bx; }
    F.a = &args;
    for (int u = F.tid; u < (LDS_BYTES - LDSCTL_OFF) / 4; u += NWAVES * 64) ((LAS unsigned*)(F.lds + LDSCTL_OFF))[u] = 0u;
    __syncthreads();
    XcdBarrier bar; bar.bar = (unsigned*)(F_ctl + CW_BAR); bar.x = 0; bar.st = nullptr;
    if (N_LAUNCHES != PER_PHASE) bar = xcd_barrier_post((unsigned*)(F_ctl + CW_BAR) + args.li * XCD_BAR_WORDS, F.MISC + 8);
#define GRID_BAR(seam) do { if (N_LAUNCHES == PER_PHASE) { if (F.tid == 0) __hip_atomic_store(F_ctl + CW_TMO, 0xBADBA0u | (unsigned)(seam), RLX_AGENT); } else { xcd_barrier(bar); } } while (0)
    const int lo = args.ph_lo, hi = args.ph_hi;
#ifndef PH_MASK
#define PH_MASK 0x3ff
#endif
#ifndef REP_MASK
#define REP_MASK 0
#endif
#define REPS(k) ((((REP_MASK) >> (k)) & 1) ? 2 : 1)
#define IN(k) ((((PH_MASK) >> (k)) & 1) && lo <= (k) && (k) < hi)
#define BOTH(k) (IN(k) && IN((k) + 1))

    if (IN(0)) { for (int rep = 0; rep < REPS(0); ++rep) { p0_mod_gemv(F); p0_transposes(F, 0, F.vcu, F.G); if (BOTH(0)) GRID_BAR(0); } }
    if (IN(1)) { for (int rep = 0; rep < REPS(1); ++rep) { p1_h1(F); if (BOTH(1)) GRID_BAR(1); } }
    if (IN(2)) {
        pg8::Gemm g{F_RB, F_WinT, D, D, D, 0x7F7F7F7Fu}; pg8::StaticOrder S; S.init(NTOK, WIN_ROWS, F.G, (int)blockIdx.x);
        pg8::EpiProj E{F_PROJ, F_GATES, NTOK};
        pg8::gemm_phase<pg8::EpiProj, pg8::StaticOrder, true, true>(F.lds + RING_OFF, g, S, E);
        { const int nun = (NTOK / 256) * (WIN_ROWS / 256), rem = nun % F.G;
          if (rem == 0) p0_transposes(F, 1, (int)blockIdx.x, F.G); else if ((int)blockIdx.x >= rem) p0_transposes(F, 1, (int)blockIdx.x - rem, F.G - rem); }
        if (BOTH(2)) GRID_BAR(2);
    }
    if (IN(3)) { for (int rep = 0; rep < REPS(3); ++rep) { p3_mlstm(F); if (BOTH(3)) GRID_BAR(3); } }
    if (IN(4)) { for (int rep = 0; rep < REPS(4); ++rep) {
        p4_combine(F);
        for (int u = blockIdx.x; u < 320; u += F.G) p4_pool_unit(F, u >> 2, u & 3);
        if (BOTH(4)) GRID_BAR(4); }
    }
    if (IN(5)) {
        { pg8::Gemm g{F_RB, F_WoutT, D, D, D, 0x7A7A7A7Au}; pg8::StaticOrder S; S.init(TAIL_PM0 * 256, D, F.G, (int)blockIdx.x);
          pg8::EpiBf16<0, false, false> E{F_HDIR, D, nullptr, 0, 1.f};
          pg8::gemm_phase<pg8::EpiBf16<0, false, false>, pg8::StaticOrder, true, true, true>(F.lds + RING_OFF, g, S, E); }
        { pg8::Gemm g{F_RB, F_WoutT, D / 2, D, D, 0x7A7A7A7Au}; pg8::SplitTail S{TAIL_PM0, TAIL_NM, D / 2, F.G, (int)blockIdx.x};
          pg8::EpiBf16<0, true, false> E{F_HDIR, D, F_MIX1, TAIL_PM0, 1.f};
          pg8::gemm_phase<pg8::EpiBf16<0, true, false>, pg8::SplitTail, true, true, true>(F.lds + RING_OFF, g, S, E); }
        if (BOTH(5)) GRID_BAR(5);
    }
    if (IN(6)) { for (int rep = 0; rep < REPS(6); ++rep) { p6_norm(F); if (BOTH(6)) GRID_BAR(6); } }
    if (IN(7)) {
        static_assert(W1_SCALE * H2_SCALE == 256.f, "sc8 below is 2^-8");
        pg8::Gemm g{F_RB, F_W1T, D, D, D, 0x7B7B7B7Bu}; pg8::StaticOrder S; S.init(NTOK, FF, F.G, (int)blockIdx.x);
        pg8::EpiF8Relu2 E{(unsigned char*)F_HFF, FF};
        pg8::gemm_phase<pg8::EpiF8Relu2, pg8::StaticOrder, true, true, true>(F.lds + RING_OFF, g, S, E);
        if (BOTH(7)) GRID_BAR(7);
    }
    if (IN(8)) {
        { pg8::Gemm g{F_HFF, F_W2T, FF, FF, FF, 0x7C7C7C7Cu}; pg8::StaticOrder S; S.init(TAIL_PM0 * 256, D, F.G, (int)blockIdx.x);
          pg8::EpiBf16<0, false, false> E{F_RB, D, nullptr, 0, 1.f};
          pg8::gemm_phase<pg8::EpiBf16<0, false, false>, pg8::StaticOrder, true, true, true>(F.lds + RING_OFF, g, S, E); }
        { pg8::Gemm g{F_HFF, F_W2T, FF / 2, FF, FF, 0x7C7C7C7Cu}; pg8::SplitTail S{TAIL_PM0, TAIL_NM, FF / 2, F.G, (int)blockIdx.x};
          pg8::EpiBf16<0, true, false> E{F_RB, D, F_Y1, TAIL_PM0, 1.f};
          pg8::gemm_phase<pg8::EpiBf16<0, true, false>, pg8::SplitTail, true, true, true>(F.lds + RING_OFF, g, S, E); }
        if (BOTH(8)) GRID_BAR(8);
    }
    if (IN(9)) { p9_final(F); }
#undef IN
#undef BOTH
}

extern "C" void kernel_launch(void* const* d_in, const int* in_sizes, int n_in, void* d_out, int out_size, void* d_ws, size_t ws_size, hipStream_t stream) {
    static int grid = 0;
    if (grid == 0) {
        if (n_in != 18 || ws_size < WS_END) { fprintf(stderr, "kernel_launch: built for 18 inputs and >= %zu bytes of workspace; got n_in %d, ws %zu; nothing launched\n", (size_t)WS_END, n_in, ws_size); grid = -1; return; }
        int dev = 0, cus = 0, per_cu = 0;
        if (hipGetDevice(&dev) != hipSuccess || hipDeviceGetAttribute(&cus, hipDeviceAttributeMultiprocessorCount, dev) != hipSuccess) { fprintf(stderr, "kernel_launch: device query failed\n"); grid = -1; return; }
        if (hipFuncSetAttribute((const void*)hymba_fwd, hipFuncAttributeMaxDynamicSharedMemorySize, LDS_BYTES) != hipSuccess) { fprintf(stderr, "kernel_launch: hipFuncSetAttribute failed\n"); grid = -1; return; }
        if (hipOccupancyMaxActiveBlocksPerMultiprocessor(&per_cu, (const void*)hymba_fwd, NWAVES * 64, LDS_BYTES) != hipSuccess || per_cu < 1)
            fprintf(stderr, "kernel_launch: note: occupancy query reports %d workgroups per CU\n", per_cu);
        (void)hipGetLastError();
        grid = cus;
    }
    if (grid < 0) return;
    if (hipMemsetAsync((char*)d_ws + WS_CTL, 0, CTL_ZERO_BYTES, stream) != hipSuccess) { fprintf(stderr, "kernel_launch: hipMemsetAsync failed\n"); return; }
    Args a{};
    for (int i = 0; i < 18; ++i) a.in[i] = (const float*)d_in[i];
    a.out = (float*)d_out; a.ws = (unsigned char*)d_ws;
    if (N_LAUNCHES == 1) {
        a.ph_lo = 0; a.ph_hi = PER_PHASE; a.li = 0;
        hipLaunchKernelGGL(hymba_fwd, dim3(grid), dim3(NWAVES * 64), LDS_BYTES, stream, a);
    } else {
        for (int li = 0; li < PER_PHASE; ++li) { a.ph_lo = li; a.ph_hi = li + 1; a.li = 0;
            hipLaunchKernelGGL(hymba_fwd, dim3(grid), dim3(NWAVES * 64), LDS_BYTES, stream, a); }
    }
    const hipError_t le = hipPeekAtLastError();
    if (le != hipSuccess) fprintf(stderr, "kernel_launch: launch failed: %s\n", hipGetErrorName(le));
}
```

```cpp
#include <hip/hip_runtime.h>
#include <cstdio>
#include <cstdint>

#ifndef MK_N_LAUNCHES
#define MK_N_LAUNCHES 1
#endif

namespace pg8 {
#define PG8_LAS __attribute__((address_space(3)))
typedef unsigned short bf16_t;
typedef short bf16x8 __attribute__((ext_vector_type(8)));
typedef float f32x4 __attribute__((ext_vector_type(4)));
typedef unsigned u32x4 __attribute__((ext_vector_type(4)));
typedef unsigned u32x2 __attribute__((ext_vector_type(2)));
typedef int v8i __attribute__((ext_vector_type(8)));
typedef int v4i __attribute__((ext_vector_type(4)));
typedef short s16x16a __attribute__((ext_vector_type(16), aligned(16)));
constexpr int BM = 256, BK = 64, HALF = 128, HTB = HALF * BK * 2, STAGE_BYTES = 8 * HTB, NXCD = 8, WGM = 8;

__host__ __device__ __forceinline__ int lds_byte(int r, int c) { const int st = (r >> 4) * 2 + (c >> 5), rr = r & 15, cc = c & 31, ob = rr * 64 + cc * 2; return st * 1024 + (ob ^ (((ob >> 9) & 1) << 5)); }
__host__ __device__ __forceinline__ void stage_rc(int b, int& R, int& C) { const int st = b / 1024, sb = b % 1024, swz = sb ^ (((sb >> 9) & 1) << 5); R = (st >> 1) * 16 + swz / 64; C = (st & 1) * 32 + (swz % 64) / 2; }
__host__ __device__ __forceinline__ int perm32(int rho) { const int n = rho >> 4, i = rho & 15; return 8 * (i >> 2) + 4 * n + (i & 3); }

struct Unit { int pm, pn, ka, kb; };
struct Gemm { const bf16_t* A; const bf16_t* Bt; int K, lda, ldb; unsigned sc8; };

struct StaticOrder {
    int nM, nN, nwg, G, c;
    __host__ __device__ void init(int M, int N, int G_, int c_) { nM = M / BM; nN = N / BM; nwg = nM * nN; G = G_; c = c_; }
    __host__ __device__ bool next(int i, Unit& u) const {
        const long L = (long)i * G + c; if (L >= nwg) return false;
        int wgid = (int)L; { const int q = nwg / NXCD, r = nwg % NXCD, xcd = wgid % NXCD, off = wgid / NXCD; wgid = (xcd < r ? xcd * (q + 1) : r * (q + 1) + (xcd - r) * q) + off; }
        const int nig = WGM * nN, gid = wgid / nig, fm = gid * WGM, gsz = (nM - fm) < WGM ? (nM - fm) : WGM;
        u.pm = fm + ((wgid % nig) % gsz); u.pn = (wgid % nig) / gsz; u.ka = 0; u.kb = 0; return true;
    }
};
struct SplitTail {
    int pm0, nMt, kh_len, G, c;
    __host__ __device__ bool next(int i, Unit& u) const {
        const int ntile = nMt * 8; const long L = (long)i * G + c; if (L >= 2 * ntile) return false;
        const int kh = (int)L / ntile; int wgid = (int)L % ntile; { const int q = ntile / NXCD, xcd = wgid % NXCD, off = wgid / NXCD; wgid = xcd * q + off; }
        const int nig = WGM * 8, gid = wgid / nig, fm = gid * WGM, gsz = (nMt - fm) < WGM ? (nMt - fm) : WGM;
        u.pm = pm0 + fm + ((wgid % nig) % gsz); u.pn = (wgid % nig) / gsz; u.ka = kh * kh_len; u.kb = kh * kh_len; return true;
    }
};
struct OneUnit {
    Unit u;
    __host__ __device__ bool next(int i, Unit& o) const { if (i) return false; o = u; return true; }
};

typedef __bf16 bf16x2_t __attribute__((ext_vector_type(2)));
__device__ __forceinline__ unsigned cvt_pk_bf16(float lo, float hi) { const bf16x2_t v = {(__bf16)lo, (__bf16)hi}; return __builtin_bit_cast(unsigned, v); }

struct EpiProj {
    static constexpr bool PERM = true;
    bf16_t* P; float* G; int ntok;
    __device__ __forceinline__ void operator()(const f32x4 (&acc)[2][2][4][2], const Unit& u, int wr, int wc, int fr, int fq) const {
        const int row0 = u.pm * BM + wr * 64 + fr;
        if (u.pn < 20) {
            const int col0 = u.pn * BM + wc * 32 + 8 * fq;
#pragma unroll
            for (int ai = 0; ai < 2; ++ai)
#pragma unroll
                for (int m = 0; m < 4; ++m) { bf16_t* rowp = P + (size_t)(row0 + ai * HALF + m * 16) * 5120 + col0;
#pragma unroll
                    for (int bj = 0; bj < 2; ++bj) { const f32x4 v0 = acc[ai][bj][m][0], v1 = acc[ai][bj][m][1];
                        u32x4 w; w.x = cvt_pk_bf16(v0[0], v0[1]); w.y = cvt_pk_bf16(v0[2], v0[3]); w.z = cvt_pk_bf16(v1[0], v1[1]); w.w = cvt_pk_bf16(v1[2], v1[3]);
                        *(u32x4*)(rowp + bj * HALF) = w; } }
        } else if (wc == 0) {
#pragma unroll
            for (int ai = 0; ai < 2; ++ai)
#pragma unroll
                for (int m = 0; m < 4; ++m) { float* gp = G + (size_t)(8 * fq) * ntok + (row0 + ai * HALF + m * 16);
#pragma unroll
                    for (int n = 0; n < 2; ++n)
#pragma unroll
                        for (int j = 0; j < 4; ++j) gp[(size_t)(4 * n + j) * ntok] = acc[ai][0][m][n][j]; }
        }
    }
};
template <int ACT, bool SPLIT, bool SCALE = true> struct EpiBf16 {
    static constexpr bool PERM = true;
    bf16_t* O; int ldc; bf16_t* O2; int pm0; float oscale;
    __device__ __forceinline__ void operator()(const f32x4 (&acc)[2][2][4][2], const Unit& u, int wr, int wc, int fr, int fq) const {
        const int col0 = u.pn * BM + wc * 32 + 8 * fq;
        bf16_t* base = O + (size_t)(u.pm * BM + wr * 64 + fr) * ldc + col0;
        if (SPLIT) { if (u.ka != 0) base = O2 + (size_t)((u.pm - pm0) * BM + wr * 64 + fr) * ldc + col0; }
#pragma unroll
        for (int ai = 0; ai < 2; ++ai)
#pragma unroll
            for (int m = 0; m < 4; ++m) { bf16_t* rowp = base + (size_t)(ai * HALF + m * 16) * ldc;
#pragma unroll
                for (int bj = 0; bj < 2; ++bj) { f32x4 v0 = acc[ai][bj][m][0], v1 = acc[ai][bj][m][1];
                    if (SCALE) { v0 = v0 * oscale; v1 = v1 * oscale; }
                    if (ACT == 1) {
#pragma unroll
                        for (int j = 0; j < 4; ++j) { const float a = fmaxf(v0[j], 0.f), b = fmaxf(v1[j], 0.f); v0[j] = a * a; v1[j] = b * b; } }
                    u32x4 w; w.x = cvt_pk_bf16(v0[0], v0[1]); w.y = cvt_pk_bf16(v0[2], v0[3]); w.z = cvt_pk_bf16(v1[0], v1[1]); w.w = cvt_pk_bf16(v1[2], v1[3]);
                    *(u32x4*)(rowp + bj * HALF) = w; } }
    }
};

struct EpiF8Relu2 {
    static constexpr bool PERM = true;
    unsigned char* O; int ldc;
    __device__ __forceinline__ void operator()(const f32x4 (&acc)[2][2][4][2], const Unit& u, int wr, int wc, int fr, int fq) const {
        unsigned char* base = O + (size_t)(u.pm * BM + wr * 64 + fr) * ldc + u.pn * BM + wc * 64 + 16 * fq;
#pragma unroll
        for (int ai = 0; ai < 2; ++ai)
#pragma unroll
            for (int m = 0; m < 4; ++m) { unsigned w[4];
#pragma unroll
                for (int bj = 0; bj < 2; ++bj) { f32x4 v0 = acc[ai][bj][m][0], v1 = acc[ai][bj][m][1];
#pragma unroll
                    for (int j = 0; j < 4; ++j) { v0[j] = __builtin_amdgcn_fmed3f(v0[j], 0.f, 21.16f); v1[j] = __builtin_amdgcn_fmed3f(v1[j], 0.f, 21.16f); }
                    v0 = v0 * v0; v1 = v1 * v1;
                    int w0 = __builtin_amdgcn_cvt_pk_fp8_f32(v0[0], v0[1], 0, false); w0 = __builtin_amdgcn_cvt_pk_fp8_f32(v0[2], v0[3], w0, true);
                    int w1 = __builtin_amdgcn_cvt_pk_fp8_f32(v1[0], v1[1], 0, false); w1 = __builtin_amdgcn_cvt_pk_fp8_f32(v1[2], v1[3], w1, true);
                    w[2 * bj] = (unsigned)w0; w[2 * bj + 1] = (unsigned)w1; }
                *(u32x4*)(base + (size_t)(ai * HALF + m * 16) * ldc) = (u32x4){w[0], w[1], w[2], w[3]}; }
    }
};

template <class E_> constexpr bool perm16_v = false;
template <> constexpr bool perm16_v<EpiF8Relu2> = true;
template <class Epi, class Sched, bool ALIGN_EPI = false, bool SP2 = false, bool F8 = false>
__device__ __forceinline__ void gemm_phase(PG8_LAS unsigned char* lds, const Gemm g, const Sched& S, const Epi& E) {
    const int tid = threadIdx.x, wid = __builtin_amdgcn_readfirstlane(tid >> 6), lane = tid & 63, wr = wid >> 2, wc = wid & 3, fr = lane & 15, fq = lane >> 4;
    constexpr int ES = F8 ? 1 : 2;
    const int K = g.K, nt = K * ES / (BK * 2);
    unsigned voffA[2], voffB[2];
#pragma unroll
    for (int i = 0; i < 2; ++i) { int R, C; stage_rc(tid * 16 + i * 8192, R, C);
        const int Rb = perm16_v<Epi> ? (64 * (R >> 5) + 16 * ((R >> 2) & 3) + 4 * ((R >> 4) & 1) + (R & 3)) : (Epi::PERM ? ((R & ~31) + perm32(R & 31)) : R);
        voffA[i] = (unsigned)(R * g.lda * ES + C * 2); voffB[i] = (unsigned)(Rb * g.ldb * ES + C * 2); }
    const size_t kstep = (size_t)(BK * 2);
    const size_t hstepA = (size_t)HALF * g.lda * ES, hstepB = (size_t)(perm16_v<Epi> ? 8 : HALF) * g.ldb * ES;
    const unsigned ldsw = (unsigned)wid * 1024u;
    const int aoff = lds_byte(wr * 64 + fr, fq * 8), boff = lds_byte(wc * 32 + fr, fq * 8);
#define PG8_UA(u) ((const char*)g.A + ((size_t)(u).pm * BM * g.lda + (size_t)(u).ka) * ES)
#define PG8_UB(u) ((const char*)g.Bt + ((size_t)(u).pn * BM * g.ldb + (size_t)(u).kb) * ES)
#define PG8_SA(b, h) (((b) * 2 + (h)) * HTB)
#define PG8_SB(b, h) ((4 + (b) * 2 + (h)) * HTB)
#define PG8_STAGE(bufoff, gbase, voff) do { _Pragma("unroll") for (int _i = 0; _i < 2; ++_i) \
        __builtin_amdgcn_global_load_lds((const unsigned*)((const char*)(gbase) + (voff)[_i]), (PG8_LAS unsigned*)(lds + (bufoff) + ldsw + _i * 8192), 16, 0, 0); } while (0)
#define PG8_LDA(dst, b, h) do { if constexpr (F8) { _Pragma("unroll") for (int m = 0; m < 4; ++m) dst##8[m] = __builtin_shufflevector(*(const PG8_LAS bf16x8*)(lds + PG8_SA(b, h) + aoff + m * 2048), *(const PG8_LAS bf16x8*)(lds + PG8_SA(b, h) + aoff + m * 2048 + 1024), 0, 1, 2, 3, 4, 5, 6, 7, 8, 9, 10, 11, 12, 13, 14, 15); } \
        else { _Pragma("unroll") for (int m = 0; m < 4; ++m) _Pragma("unroll") for (int k = 0; k < 2; ++k) dst[m][k] = *(const PG8_LAS bf16x8*)(lds + PG8_SA(b, h) + aoff + m * 2048 + k * 1024); } } while (0)
#define PG8_LDB(dst, b, h) do { if constexpr (F8) { _Pragma("unroll") for (int n = 0; n < 2; ++n) dst##8[n] = __builtin_shufflevector(*(const PG8_LAS bf16x8*)(lds + PG8_SB(b, h) + boff + n * 2048), *(const PG8_LAS bf16x8*)(lds + PG8_SB(b, h) + boff + n * 2048 + 1024), 0, 1, 2, 3, 4, 5, 6, 7, 8, 9, 10, 11, 12, 13, 14, 15); } \
        else { _Pragma("unroll") for (int n = 0; n < 2; ++n) _Pragma("unroll") for (int k = 0; k < 2; ++k) dst[n][k] = *(const PG8_LAS bf16x8*)(lds + PG8_SB(b, h) + boff + n * 2048 + k * 1024); } } while (0)
#define PG8_MMA(ai, bj, At, Bt) do { __builtin_amdgcn_s_setprio(1); _Pragma("unroll") for (int m = 0; m < 4; ++m) _Pragma("unroll") for (int n = 0; n < 2; ++n) { \
        if constexpr (F8) asm volatile("v_mfma_scale_f32_16x16x128_f8f6f4 %0, %1, %2, %0, %3, %3 op_sel_hi:[0,0,0]" : "+v"(acc[ai][bj][m][n]) : "v"(Bt##8[n]), "v"(At##8[m]), "v"(scv)); \
        else { _Pragma("unroll") for (int k = 0; k < 2; ++k) acc[ai][bj][m][n] = __builtin_amdgcn_mfma_f32_16x16x32_bf16(Bt[n][k], At[m][k], acc[ai][bj][m][n], 0, 0, 0); } } \
        __builtin_amdgcn_s_setprio(0); } while (0)
#define PG8_WAIT_V(n) asm volatile("s_waitcnt vmcnt(" #n ")" ::: "memory")
#define PG8_WAIT_L(n) asm volatile("s_waitcnt lgkmcnt(" #n ")" ::: "memory")
#define PG8_BAR __builtin_amdgcn_s_barrier()
#define PG8_SCHED __builtin_amdgcn_sched_barrier(0)
    Unit cur, nxt; int ui = 0; const unsigned scv = g.sc8;
    if (!S.next(0, cur)) return;
    f32x4 acc[2][2][4][2];
#pragma unroll
    for (int a = 0; a < 2; ++a)
#pragma unroll
        for (int b = 0; b < 2; ++b)
#pragma unroll
            for (int m = 0; m < 4; ++m)
#pragma unroll
                for (int n = 0; n < 2; ++n) acc[a][b][m][n] = (f32x4){0.f, 0.f, 0.f, 0.f};
    bf16x8 At[4][2], B0[2][2], B1[2][2]; s16x16a At8[4], B08[2], B18[2];
    const char* cA = PG8_UA(cur); const char* cB = PG8_UB(cur);
    if constexpr (SP2) {
        PG8_STAGE(PG8_SB(0, 0), cB, voffB); PG8_STAGE(PG8_SB(0, 1), cB + hstepB, voffB); PG8_STAGE(PG8_SA(0, 0), cA, voffA); PG8_STAGE(PG8_SA(0, 1), cA + hstepA, voffA);
        if (wr == 1) PG8_BAR;
        PG8_WAIT_V(2); PG8_BAR;
        PG8_STAGE(PG8_SB(1, 0), cB + kstep, voffB); PG8_STAGE(PG8_SA(1, 0), cA + kstep, voffA); PG8_STAGE(PG8_SB(1, 1), cB + hstepB + kstep, voffB);
        PG8_WAIT_V(6); PG8_BAR;
    } else {
        PG8_STAGE(PG8_SB(0, 0), cB, voffB); PG8_STAGE(PG8_SA(0, 0), cA, voffA); PG8_STAGE(PG8_SB(0, 1), cB + hstepB, voffB); PG8_STAGE(PG8_SA(0, 1), cA + hstepA, voffA);
        if (wr == 1) PG8_BAR;
        PG8_WAIT_V(4); PG8_BAR;
        PG8_STAGE(PG8_SB(1, 0), cB + kstep, voffB); PG8_STAGE(PG8_SA(1, 0), cA + kstep, voffA); PG8_STAGE(PG8_SB(1, 1), cB + hstepB + kstep, voffB);
        PG8_WAIT_V(6); PG8_BAR;
    }
    for (;;) {
        const bool has_next = S.next(ui + 1, nxt);
        const char* nA = has_next ? PG8_UA(nxt) : cA; const char* nB = has_next ? PG8_UB(nxt) : cB;
        for (int t = 0; t < nt; t += 2) {
            const bool last = (t == nt - 2);
            const char* a1 = cA + (size_t)(t + 1) * kstep;
            const char* a2 = last ? nA : cA + (size_t)(t + 2) * kstep; const char* b2 = last ? nB : cB + (size_t)(t + 2) * kstep;
            const char* a3 = a2 + kstep; const char* b3 = b2 + kstep;
            if constexpr (SP2) {
            PG8_LDB(B0, 0, 0); PG8_LDB(B1, 0, 1); PG8_SCHED; PG8_LDA(At, 0, 0); PG8_STAGE(PG8_SA(1, 1), a1 + hstepA, voffA);
            PG8_WAIT_V(8); PG8_WAIT_L(0); PG8_BAR; PG8_MMA(0, 0, At, B0); PG8_MMA(0, 1, At, B1); PG8_BAR; PG8_SCHED;
            PG8_LDA(At, 0, 1); PG8_STAGE(PG8_SB(0, 0), b2, voffB); PG8_STAGE(PG8_SB(0, 1), b2 + hstepB, voffB); PG8_STAGE(PG8_SA(0, 0), a2, voffA);
            PG8_WAIT_V(8); PG8_WAIT_L(0); PG8_BAR; PG8_MMA(1, 0, At, B0); PG8_MMA(1, 1, At, B1); PG8_BAR; PG8_SCHED;
            PG8_LDB(B0, 1, 0); PG8_LDB(B1, 1, 1); PG8_SCHED; PG8_LDA(At, 1, 0); PG8_STAGE(PG8_SA(0, 1), a2 + hstepA, voffA);
            PG8_WAIT_V(8); PG8_WAIT_L(0); PG8_BAR; PG8_MMA(0, 0, At, B0); PG8_MMA(0, 1, At, B1); PG8_BAR; PG8_SCHED;
            PG8_LDA(At, 1, 1); PG8_STAGE(PG8_SB(1, 0), b3, voffB); PG8_STAGE(PG8_SB(1, 1), b3 + hstepB, voffB); PG8_STAGE(PG8_SA(1, 0), a3, voffA);
            PG8_WAIT_V(8); PG8_WAIT_L(0); PG8_BAR; PG8_MMA(1, 0, At, B0); PG8_MMA(1, 1, At, B1); PG8_BAR; PG8_SCHED;
            } else {
            PG8_LDB(B0, 0, 0); PG8_SCHED; PG8_LDA(At, 0, 0); PG8_STAGE(PG8_SA(1, 1), a1 + hstepA, voffA);
            PG8_WAIT_L(8); PG8_BAR; PG8_WAIT_L(0); PG8_MMA(0, 0, At, B0); PG8_BAR; PG8_SCHED;
            PG8_LDB(B1, 0, 1); PG8_STAGE(PG8_SB(0, 0), b2, voffB);
            PG8_BAR; PG8_WAIT_L(0); PG8_MMA(0, 1, At, B1); PG8_BAR;
            PG8_LDA(At, 0, 1); PG8_STAGE(PG8_SA(0, 0), a2, voffA);
            PG8_BAR; PG8_WAIT_L(0); PG8_MMA(1, 0, At, B0); PG8_BAR; PG8_SCHED;
            PG8_STAGE(PG8_SB(0, 1), b2 + hstepB, voffB);
            PG8_WAIT_V(6); PG8_BAR; PG8_MMA(1, 1, At, B1); PG8_BAR;
            PG8_LDB(B0, 1, 0); PG8_SCHED; PG8_LDA(At, 1, 0); PG8_STAGE(PG8_SA(0, 1), a2 + hstepA, voffA);
            PG8_WAIT_L(8); PG8_BAR; PG8_WAIT_L(0); PG8_MMA(0, 0, At, B0); PG8_BAR; PG8_SCHED;
            PG8_LDB(B1, 1, 1); PG8_STAGE(PG8_SB(1, 0), b3, voffB);
            PG8_BAR; PG8_WAIT_L(0); PG8_MMA(0, 1, At, B1); PG8_BAR;
            PG8_LDA(At, 1, 1); PG8_STAGE(PG8_SA(1, 0), a3, voffA);
            PG8_BAR; PG8_WAIT_L(0); PG8_MMA(1, 0, At, B0); PG8_BAR; PG8_SCHED;
            PG8_STAGE(PG8_SB(1, 1), b3 + hstepB, voffB);
            PG8_WAIT_V(6); PG8_BAR; PG8_MMA(1, 1, At, B1); PG8_BAR;
            }
        }
        if constexpr (ALIGN_EPI) { if (wr == 0) PG8_BAR; }
        if constexpr (F8) asm volatile("s_nop 15\n\ts_nop 15" ::: "memory");
        E(acc, cur, wr, wc, fr, fq);
        if (!has_next) break;
#pragma unroll
        for (int a = 0; a < 2; ++a)
#pragma unroll
            for (int b = 0; b < 2; ++b)
#pragma unroll
                for (int m = 0; m < 4; ++m)
#pragma unroll
                    for (int n = 0; n < 2; ++n) acc[a][b][m][n] = (f32x4){0.f, 0.f, 0.f, 0.f};
        cur = nxt; cA = nA; cB = nB; ++ui;
        if constexpr (ALIGN_EPI) { if (wr == 1) PG8_BAR; }
    }
    PG8_WAIT_V(0);
    if constexpr (!ALIGN_EPI) { if (wr == 0) PG8_BAR; }
    PG8_BAR;
#undef PG8_UA
#undef PG8_UB
#undef PG8_SA
#undef PG8_SB
#undef PG8_STAGE
#undef PG8_LDA
#undef PG8_LDB
#undef PG8_MMA
#undef PG8_WAIT_V
#undef PG8_WAIT_L
#undef PG8_BAR
#undef PG8_SCHED
}
}

constexpr int NWAVES = 8;
constexpr int N_LAUNCHES = MK_N_LAUNCHES;
constexpr int PER_PHASE = 10;
constexpr int D = 2048, NCTX = 16 * 256, NLAT = 8 * 2048, NTOK = NCTX + NLAT;
constexpr int MW = 1024, NH = 8, DH = 128, PW = 1024, FF = 8192;
constexpr int PROJ_LD = 5120;
constexpr int WIN_ROWS = 5376;
constexpr float EPS = 1e-6f;
constexpr int NMOD = 9;

constexpr size_t MiB = 1u << 20;
constexpr size_t WS_CTL = 0, CTL_ZERO_BYTES = 1 * MiB;
constexpr size_t WS_MOD = 1 * MiB;
constexpr size_t WS_GATES = 2 * MiB;
constexpr int TAIL_PM0 = 64, TAIL_NM = 16;
constexpr size_t WS_POOLWT = 11 * MiB;
constexpr size_t WS_WU = 5 * MiB;
constexpr size_t WS_WIN = 12 * MiB;
constexpr size_t WS_WOUT = 33 * MiB;
constexpr size_t WS_W1 = 41 * MiB;
constexpr size_t WS_W2 = 73 * MiB;
constexpr size_t WS_RB = 108 * MiB;
constexpr size_t WS_PROJ = 188 * MiB;
constexpr size_t WS_HDIR = 388 * MiB;
constexpr size_t WS_PP = 468 * MiB;
constexpr size_t WS_HFF = 188 * MiB;
constexpr size_t WS_END = 508 * MiB;
constexpr int CW_TMO = 0, CW_CODE = 1;
constexpr int CW_BAR = 4096;

constexpr int RING_OFF = 0;
constexpr int KLD = 144, VLD = 80;
constexpr int ML_KB = 0, ML_KB_SZ = 36864;
constexpr int ML_VB = 73728, ML_VB_SZ = 20480;
constexpr int ML_CT = 114688, ML_CT_SZ = 18944;
constexpr int ML_G = 154112, ML_G_SZ = 2048;
constexpr int ML_SC = 158208;
constexpr int LDSCTL_OFF = 158720, MISC_OFF = LDSCTL_OFF + 320;
constexpr int LDS_BYTES = 159744;

#define GAS __attribute__((address_space(1)))
#define LAS __attribute__((address_space(3)))
typedef unsigned short bf16;
typedef unsigned v4u __attribute__((ext_vector_type(4)));
typedef unsigned v2u __attribute__((ext_vector_type(2)));
typedef float f32x4 __attribute__((ext_vector_type(4)));
typedef short bf16x8 __attribute__((ext_vector_type(8)));
typedef GAS unsigned gu32;
#define RLX_AGENT __ATOMIC_RELAXED, __HIP_MEMORY_SCOPE_AGENT
#define LDS_WAIT() asm volatile("s_waitcnt lgkmcnt(0)" ::: "memory")
#define VM_WAIT() asm volatile("s_waitcnt vmcnt(0)" ::: "memory")
typedef __bf16 bf16x2_t __attribute__((ext_vector_type(2)));
__device__ __forceinline__ unsigned pk2(float lo, float hi) { const bf16x2_t v = {(__bf16)lo, (__bf16)hi}; return __builtin_bit_cast(unsigned, v); }
__device__ __forceinline__ float bflo(unsigned w) { return __uint_as_float(w << 16); }
__device__ __forceinline__ float bfhi(unsigned w) { return __uint_as_float(w & 0xffff0000u); }
__device__ __forceinline__ float bf2f(bf16 b) { return __uint_as_float((unsigned)b << 16); }

#define XB_TMO      128
#define XB_XCNT(j)  (256  + 64 * (j))
#define XB_XSUB(j)  (1280 + 64 * (j))
#define XB_XGEN(j)  (2304 + 64 * (j))
#define XB_TOP      3328
#define XB_TOPGEN   3392
#define XCD_BAR_WORDS 3456
#define XB_SPIN_CAP (1u << 18)
__device__ __forceinline__ unsigned xb_ld(unsigned* p)              { return __hip_atomic_load(p, __ATOMIC_RELAXED, __HIP_MEMORY_SCOPE_AGENT); }
__device__ __forceinline__ unsigned xb_add(unsigned* p, unsigned v) { return __hip_atomic_fetch_add(p, v, __ATOMIC_RELAXED, __HIP_MEMORY_SCOPE_AGENT); }
__device__ __forceinline__ unsigned xb_xcc_id() { return (unsigned)__builtin_amdgcn_s_getreg((3 << 11) | 20) & 0xFu; }
#define XB_SPIN(cond, bar) do { unsigned _sp = 0; while (cond) { __builtin_amdgcn_s_sleep(1); \
    if ((++_sp & 255u) == 0u) { if (xb_ld(&(bar)[XB_TMO])) break; if (_sp > XB_SPIN_CAP) { atomicAdd(&(bar)[XB_TMO], 1u); break; } } } } while (0)
struct XcdBarrier { unsigned* bar; unsigned x; volatile LAS unsigned* st; };
__device__ __forceinline__ XcdBarrier xcd_barrier_post(unsigned* bar, volatile LAS unsigned* st) {
    XcdBarrier b; b.bar = bar; b.x = xb_xcc_id(); b.st = st;
    if (threadIdx.x == 0) (void)xb_add(&bar[XB_XCNT(b.x)], 1u);
    return b;
}
__device__ __forceinline__ void xcd_barrier_complete(unsigned* bar, unsigned x, unsigned& nloc, unsigned& nx) {
    const unsigned G = gridDim.x * gridDim.y * gridDim.z;
    unsigned sum, cnt, mine, sp = 0u;
    for (;;) {
        sum = 0u; cnt = 0u; mine = 0u;
#pragma unroll
        for (unsigned j = 0; j < 16; ++j) { const unsigned c = xb_ld(&bar[XB_XCNT(j)]); sum += c; cnt += (c > 0u) ? 1u : 0u; mine = (j == x) ? c : mine; }
        if (sum == G) break;
        __builtin_amdgcn_s_sleep(1);
        if ((++sp & 255u) == 0u) { if (xb_ld(&bar[XB_TMO])) break; if (sp > XB_SPIN_CAP) { atomicAdd(&bar[XB_TMO], 1u); break; } }
    }
    nloc = mine > 0u ? mine : 1u; nx = cnt > 0u ? cnt : 1u;
}
__device__ __forceinline__ void xcd_barrier(const XcdBarrier& b) {
    asm volatile("s_waitcnt vmcnt(0)" ::: "memory");
    __syncthreads();
    if (threadIdx.x == 0) {
        unsigned* bar = b.bar;
        __builtin_amdgcn_s_waitcnt(0);
        unsigned nloc = b.st[0], nx = b.st[1];
        if (nloc == 0u) { xcd_barrier_complete(bar, b.x, nloc, nx); b.st[0] = nloc; b.st[1] = nx; }
        const unsigned old = xb_add(&bar[XB_XSUB(b.x)], 1u);
        const unsigned gen = old / nloc;
        if (old + 1u == (gen + 1u) * nloc) {
            __builtin_amdgcn_fence(__ATOMIC_RELEASE, "agent");
            asm volatile("s_waitcnt vmcnt(0)" ::: "memory");
            const unsigned og = xb_add(&bar[XB_TOP], 1u);
            const unsigned tg = og / nx;
            if (og + 1u == (tg + 1u) * nx) xb_add(&bar[XB_TOPGEN], 1u);
            else XB_SPIN(xb_ld(&bar[XB_TOPGEN]) == tg, bar);
            __builtin_amdgcn_fence(__ATOMIC_ACQUIRE, "agent");
            xb_add(&bar[XB_XGEN(b.x)], 1u);
            asm volatile("s_waitcnt vmcnt(0)" ::: "memory");
        } else {
            XB_SPIN(xb_ld(&bar[XB_XGEN(b.x)]) == gen, bar);
            __builtin_amdgcn_fence(__ATOMIC_ACQUIRE, "agent");
            asm volatile("s_waitcnt vmcnt(0)" ::: "memory");
        }
    }
    __syncthreads();
}

struct Args { const float* in[18]; float* out; unsigned char* ws; int ph_lo, ph_hi, li, pad; };
struct Frame {
    LAS unsigned char* lds;
    volatile LAS unsigned* MISC;
    int tid, lane, wave;
    int vcu, G;
    const Args* a;
};
#define F_xp (F.a->in[0])
#define F_xs (F.a->in[1])
#define F_cc (F.a->in[2])
#define F_stC (F.a->in[3])
#define F_stN (F.a->in[4])
#define F_stM (F.a->in[5])
#define F_cctx (F.a->in[6])
#define F_w_in (F.a->in[7])
#define F_gate_bias (F.a->in[8])
#define F_mnw (F.a->in[9])
#define F_pool_w (F.a->in[10])
#define F_pool_scale (F.a->in[11])
#define F_w_out (F.a->in[12])
#define F_ada_w (F.a->in[13])
#define F_ada_b (F.a->in[14])
#define F_norm_w (F.a->in[15])
#define F_w1 (F.a->in[16])
#define F_w2 (F.a->in[17])
#define F_out (F.a->out)
#define F_ctl ((gu32*)(F.a->ws + WS_CTL))
#define F_MOD ((float*)(F.a->ws + WS_MOD))
#define F_GATES ((float*)(F.a->ws + WS_GATES))
#define F_MIX1 ((bf16*)(F.a->ws + WS_PP))
#define F_Y1 ((bf16*)(F.a->ws + WS_WIN))
#define F_PoolWT ((bf16*)(F.a->ws + WS_POOLWT))
#define F_WU ((bf16*)(F.a->ws + WS_WU))
#define F_WinT ((bf16*)(F.a->ws + WS_WIN))
#define F_WoutT ((bf16*)(F.a->ws + WS_WOUT))
#define F_W1T ((bf16*)(F.a->ws + WS_W1))
#define F_W2T ((bf16*)(F.a->ws + WS_W2))
#define F_RB ((bf16*)(F.a->ws + WS_RB))
#define F_PROJ ((bf16*)(F.a->ws + WS_PROJ))
#define F_HDIR ((bf16*)(F.a->ws + WS_HDIR))
#define F_HFF ((bf16*)(F.a->ws + WS_HFF))

__device__ __forceinline__ int fresh_lane() { int l; asm volatile("v_mbcnt_lo_u32_b32 %0, -1, 0\n\tv_mbcnt_hi_u32_b32 %0, -1, %0" : "=v"(l)); return l; }
__device__ __forceinline__ float wave_sum(float v) {
#pragma unroll
    for (int o = 1; o < 64; o <<= 1) v += __shfl_xor(v, o);
    return v;
}
__device__ __forceinline__ const float* xrow_ptr(const Frame& F, int m) { return m < NCTX ? F_xp + (size_t)m * D : F_xs + (size_t)(m - NCTX) * D; }
__device__ __forceinline__ int modrow(int m) { return m < NCTX ? 0 : 1 + ((m - NCTX) >> 11); }

constexpr float W1_SCALE = 32.f, H2_SCALE = 8.f;
__device__ __forceinline__ void p0_transpose_item(const float* W, int N, bf16* WT, int ldk, int k0, int n0, int drow0, LAS float* scr, int lane, const float* nscale = nullptr, float cscale = 1.f) {
    { const int kr = lane >> 3, nq = lane & 7; f32x4 v[8];
#pragma unroll
        for (int i = 0; i < 8; ++i) v[i] = __builtin_nontemporal_load((const GAS f32x4*)(W + (size_t)(k0 + 8 * i + kr) * N + n0 + 4 * nq));
#pragma unroll
        for (int i = 0; i < 8; ++i) { LAS float* d = scr + (8 * i + kr) * 33 + 4 * nq; d[0] = v[i].x; d[1] = v[i].y; d[2] = v[i].z; d[3] = v[i].w; } }
    LDS_WAIT(); asm volatile("" ::: "memory");
    const int c = lane & 7;
#pragma unroll
    for (int j = 0; j < 4; ++j) { const int n = (lane >> 3) + 8 * j; const LAS float* s = scr + (8 * c) * 33 + n;
        const float sc = (nscale ? nscale[n] : 1.f) * cscale;
        v4u o; o.x = pk2(s[0 * 33] * sc, s[1 * 33] * sc); o.y = pk2(s[2 * 33] * sc, s[3 * 33] * sc); o.z = pk2(s[4 * 33] * sc, s[5 * 33] * sc); o.w = pk2(s[6 * 33] * sc, s[7 * 33] * sc);
        *(GAS v4u*)(WT + (size_t)(drow0 + n) * ldk + k0 + 8 * c) = o; }
    LDS_WAIT(); asm volatile("" ::: "memory");
}
__device__ __forceinline__ void p0_transpose_item_f8(const float* W, int N, unsigned char* WT, int ldk, int k0, int n0, LAS float* scr, int lane, float sc) {
    { const int kr = lane >> 3, nq = lane & 7; f32x4 v[8];
#pragma unroll
        for (int i = 0; i < 8; ++i) v[i] = __builtin_nontemporal_load((const GAS f32x4*)(W + (size_t)(k0 + 8 * i + kr) * N + n0 + 4 * nq));
#pragma unroll
        for (int i = 0; i < 8; ++i) { LAS float* d = scr + (8 * i + kr) * 33 + 4 * nq; d[0] = v[i].x; d[1] = v[i].y; d[2] = v[i].z; d[3] = v[i].w; } }
    LDS_WAIT(); asm volatile("" ::: "memory");
    const int c = lane & 7;
#pragma unroll
    for (int j = 0; j < 4; ++j) { const int n = (lane >> 3) + 8 * j; const LAS float* s = scr + (8 * c) * 33 + n;
        int w0 = __builtin_amdgcn_cvt_pk_fp8_f32(s[0 * 33] * sc, s[1 * 33] * sc, 0, false); w0 = __builtin_amdgcn_cvt_pk_fp8_f32(s[2 * 33] * sc, s[3 * 33] * sc, w0, true);
        int w1 = __builtin_amdgcn_cvt_pk_fp8_f32(s[4 * 33] * sc, s[5 * 33] * sc, 0, false); w1 = __builtin_amdgcn_cvt_pk_fp8_f32(s[6 * 33] * sc, s[7 * 33] * sc, w1, true);
        *(GAS v2u*)(WT + (size_t)(n0 + n) * ldk + k0 + 8 * c) = (v2u){(unsigned)w0, (unsigned)w1}; }
    LDS_WAIT(); asm volatile("" ::: "memory");
}
__device__ __forceinline__ void p0_transposes(Frame& F, int part, int wg, int nwg) {
    LAS float* scr = (LAS float*)(F.lds + RING_OFF + F.wave * 16384);
    const int gw = wg * NWAVES + F.wave, NGW = nwg * NWAVES;
    constexpr int I_IN = (D / 64) * (5152 / 32), I_OUT = (D / 64) * (D / 32), I_1 = (D / 64) * (FF / 32), I_2 = (FF / 64) * (D / 32), I_P = 4 * (256 / 64) * (256 / 32);
    if (part == 0) {
        constexpr int NB = 4128 / 32, I_INQ = (D / 64) * NB, I_WU = D;
        for (int it = gw; it < I_INQ + I_P + I_WU; it += NGW) { int r = it;
            if (r < I_INQ) { const int kb = r / NB, nb = r % NB, n0 = 32 * nb; const int dr = n0 < 4096 ? n0 : 5120;
                p0_transpose_item(F_w_in, 5152, F_WinT, D, 64 * kb, n0, dr, scr, F.lane, nullptr, n0 < 1024 ? 0.08838834764831845f : 1.f); continue; } r -= I_INQ;
            if (r < I_P) { const int g = r / 32, q = r % 32, kb = q / 8, nb = q % 8; p0_transpose_item(F_pool_w + (size_t)g * 65536, 256, F_PoolWT, 256, 64 * kb, 32 * nb, g * 256 + 32 * nb, scr, F.lane, F_pool_scale + g * 256 + 32 * nb); continue; } r -= I_P;
            { const GAS f32x4* s = (const GAS f32x4*)(F_w_in + (size_t)r * 5152 + 4128) + 4 * F.lane; const f32x4 a = s[0], b = s[1], c = s[2], d = s[3];
              GAS v4u* o = (GAS v4u*)(F_WU + (size_t)r * 1024) + 2 * F.lane; o[0] = (v4u){pk2(a.x, a.y), pk2(a.z, a.w), pk2(b.x, b.y), pk2(b.z, b.w)}; o[1] = (v4u){pk2(c.x, c.y), pk2(c.z, c.w), pk2(d.x, d.y), pk2(d.z, d.w)}; } }
        return;
    }
    constexpr int NITEMS = I_OUT + I_1 + I_2;
    for (int it = gw; it < NITEMS; it += NGW) {
        int r = it;
        if (r < I_OUT) { const int nblk = D / 32, kb = r / nblk, nb = r % nblk; p0_transpose_item_f8(F_w_out, D, (unsigned char*)F_WoutT, D, 64 * kb, 32 * nb, scr, F.lane, 64.f); continue; } r -= I_OUT;
        if (r < I_1) { const int nblk = FF / 32, kb = r / nblk, nb = r % nblk; p0_transpose_item_f8(F_w1, FF, (unsigned char*)F_W1T, D, 64 * kb, 32 * nb, scr, F.lane, W1_SCALE); continue; } r -= I_1;
        { const int nblk = D / 32, kb = r / nblk, nb = r % nblk; p0_transpose_item_f8(F_w2, D, (unsigned char*)F_W2T, FF, 64 * kb, 32 * nb, scr, F.lane, 64.f); }
    }
}
__device__ __forceinline__ void p0_mod_gemv(Frame& F) {
    LAS float* sil = (LAS float*)(F.lds);
    LAS float* red = (LAS float*)(F.lds + 73728);
    bool have = false;
    for (int item = F.vcu; item < 192; item += F.G) {
        if (!have) {
            { float cv[4][NMOD];
#pragma unroll
                for (int j = 0; j < 4; ++j) { const int k = F.tid + 512 * j; cv[j][0] = F_cctx[k];
#pragma unroll
                    for (int r = 1; r < NMOD; ++r) cv[j][r] = F_cc[(size_t)(r - 1) * D + k]; }
#pragma unroll
                for (int j = 0; j < 4; ++j) { const int k = F.tid + 512 * j;
#pragma unroll
                    for (int r = 0; r < NMOD; ++r) { const float c = cv[j][r]; sil[k * NMOD + r] = c / (1.f + __expf(-c)); } } }
            have = true;
        }
        __syncthreads();
        const int n0 = item * 64, kq = F.tid >> 4, c4 = F.tid & 15;
        float acc[NMOD][4];
#pragma unroll
        for (int r = 0; r < NMOD; ++r) { acc[r][0] = 0.f; acc[r][1] = 0.f; acc[r][2] = 0.f; acc[r][3] = 0.f; }
        const GAS f32x4* wp = (const GAS f32x4*)(F_ada_w + n0) + c4;
        for (int ib = 0; ib < 64; ib += 16) {
            f32x4 wv[16];
#pragma unroll
            for (int j = 0; j < 16; ++j) wv[j] = wp[(size_t)(kq + 32 * (ib + j)) * (12288 / 4)];
#pragma unroll
            for (int j = 0; j < 16; ++j) { const int k = kq + 32 * (ib + j); const f32x4 w = wv[j];
                if ((j & 3) == 0) __builtin_amdgcn_sched_barrier(0);
#pragma unroll
                for (int r = 0; r < NMOD; ++r) { const float s = sil[k * NMOD + r]; acc[r][0] += s * w.x; acc[r][1] += s * w.y; acc[r][2] += s * w.z; acc[r][3] += s * w.w; } } }
#pragma unroll
        for (int r = 0; r < NMOD; ++r)
#pragma unroll
            for (int j = 0; j < 4; ++j) { float v = acc[r][j]; v += __shfl_xor(v, 16); v += __shfl_xor(v, 32); acc[r][j] = v; }
        if (F.lane < 16) {
#pragma unroll
            for (int r = 0; r < NMOD; ++r)
#pragma unroll
                for (int j = 0; j < 4; ++j) red[(F.wave * NMOD + r) * 64 + 4 * c4 + j] = acc[r][j];
        }
        __syncthreads();
        for (int o = F.tid; o < NMOD * 64; o += NWAVES * 64) { const int r = o / 64, c = o % 64; float s = F_ada_b[n0 + c];
#pragma unroll
            for (int w = 0; w < 8; ++w) s += red[(w * NMOD + r) * 64 + c];
            F_MOD[(size_t)r * 12288 + n0 + c] = s; }
    }
    __syncthreads();
}
struct RowSeg { int lo, hi, mr; };
__device__ __forceinline__ bool next_seg(int& cur, int r_hi, RowSeg& s) {
    if (cur >= r_hi) return false;
    s.lo = cur; s.mr = modrow(cur); const int bound = s.mr == 0 ? NCTX : NCTX + s.mr * 2048; s.hi = bound < r_hi ? bound : r_hi; cur = s.hi; return true;
}
__device__ __forceinline__ void p1_h1(Frame& F) {
    const int lane = fresh_lane();
    const int bx = blockIdx.x; int r_lo, r_hi;
    if (F.G == 256) { r_lo = bx < 32 ? 66 * bx : 2112 + 82 * (bx - 32); r_hi = r_lo + (bx < 32 ? 66 : 82); } else { const int rp = (NTOK + F.G - 1) / F.G; r_lo = min(NTOK, bx * rp); r_hi = min(NTOK, r_lo + rp); }
    for (int u = bx; u < 32; u += F.G) {
        pg8::Gemm gm{F_PoolWT, F_WU, 256, 256, 1024, 0x7F7F7F7Fu};
        pg8::OneUnit S{{u >> 3, u & 7, 0, 256 * (u >> 3)}};
        pg8::EpiBf16<0, false> E{F_WinT + (size_t)4096 * D, D, nullptr, 0, 1.f};
        pg8::gemm_phase<pg8::EpiBf16<0, false>, pg8::OneUnit, false, true>(F.lds + RING_OFF, gm, S, E);
    }
    LAS f32x4* pA = (LAS f32x4*)(F.lds); LAS f32x4* pC = pA + D / 4;
    int cur = r_lo; RowSeg sg;
    while (next_seg(cur, r_hi, sg)) {
        const float* mod = F_MOD + (size_t)sg.mr * 12288;
        for (int i = F.tid; i < D / 4; i += NWAVES * 64) { const f32x4 w = *(const f32x4*)(F_norm_w + 4 * i), sc = *(const f32x4*)(mod + 2048 + 4 * i); pA[i] = w * (sc + 1.f); pC[i] = *(const f32x4*)(mod + 4 * i); }
        __syncthreads();
        for (int m = sg.lo + F.wave; m < sg.hi; m += NWAVES) {
            const GAS f32x4* xr = (const GAS f32x4*)xrow_ptr(F, m) + lane;
            f32x4 v[8]; float s = 0.f;
#pragma unroll
            for (int j = 0; j < 8; ++j) { v[j] = xr[64 * j]; s += (v[j].x * v[j].x + v[j].y * v[j].y) + (v[j].z * v[j].z + v[j].w * v[j].w); }
            const float rstd = rsqrtf(wave_sum(s) * (1.f / D) + EPS);
            GAS v2u* o8 = (GAS v2u*)(F_RB + (size_t)m * D) + lane;
#pragma unroll
            for (int j = 0; j < 8; ++j) { const f32x4 h = v[j] * rstd * pA[lane + 64 * j] + pC[lane + 64 * j];
                v2u o; o.x = pk2(h.x, h.y); o.y = pk2(h.z, h.w); o8[64 * j] = o; }
        }
        __syncthreads();
    }
}
typedef short s16x4 __attribute__((ext_vector_type(4)));
__device__ __forceinline__ bf16x8 tr_pair(const LAS bf16* p, int ld) {
    const s16x4 a = __builtin_amdgcn_ds_read_tr16_b64_v4i16((LAS s16x4*)p);
    const s16x4 b = __builtin_amdgcn_ds_read_tr16_b64_v4i16((LAS s16x4*)(p + 16 * ld));
    return (bf16x8){a[0], a[1], a[2], a[3], b[0], b[1], b[2], b[3]};
}
struct GatePre { float gi0, gi1, gf0, gf1; };
__device__ __forceinline__ GatePre gate_load(const float* GATES, int seqbase, int T, int dir, int c, int lane, int gi_col, int gf_col) {
    typedef float f32x2_t __attribute__((ext_vector_type(2)));
    const int j0 = c * 128 + 2 * lane, lo = dir ? T - 2 - j0 : j0;
    const f32x2_t vi = *(const GAS f32x2_t*)(GATES + (size_t)gi_col * NTOK + seqbase + lo), vf = *(const GAS f32x2_t*)(GATES + (size_t)gf_col * NTOK + seqbase + lo);
    GatePre g; g.gi0 = dir ? vi.y : vi.x; g.gi1 = dir ? vi.x : vi.y; g.gf0 = dir ? vf.y : vf.x; g.gf1 = dir ? vf.x : vf.y; return g;
}
__device__ __forceinline__ float logsig(float x) { return fminf(x, 0.f) - log1pf(__expf(-fabsf(x))); }
__device__ __forceinline__ float gate_finish(const GatePre g, float bias_i, float bias_f, float mchunk, LAS float* gb, LAS float* sc, int lane) {
    const float li0 = g.gi0 + bias_i, li1 = g.gi1 + bias_i, lf0 = logsig(g.gf0 + bias_f), lf1 = logsig(g.gf1 + bias_f);
    const float c1 = lf0 + lf1; float incl = c1;
#pragma unroll
    for (int o = 1; o < 64; o <<= 1) { const float v = __shfl_up(incl, o); if (lane >= o) incl += v; }
    const float excl = incl - c1, b0 = excl + lf0, b1 = incl;
    const float a0 = li0 - b0, a1 = li1 - b1, p1 = fmaxf(a0, a1); float im = p1;
#pragma unroll
    for (int o = 1; o < 64; o <<= 1) { const float v = __shfl_up(im, o); if (lane >= o) im = fmaxf(im, v); }
    float em = __shfl_up(im, 1); if (lane == 0) em = -INFINITY;
    const float M0 = fmaxf(mchunk, fmaxf(em, a0)), M1 = fmaxf(mchunk, im);
    const float Mlast = __shfl(M1, 63), blast = __shfl(b1, 63);
    typedef float f32x2 __attribute__((ext_vector_type(2)));
    *(LAS f32x2*)(gb + 2 * lane) = (f32x2){a0 * 1.44269504089f, a1 * 1.44269504089f};
    *(LAS f32x2*)(gb + 128 + 2 * lane) = (f32x2){M0, M1};
    *(LAS f32x2*)(gb + 256 + 2 * lane) = (f32x2){b0 + M0, b1 + M1};
    *(LAS f32x2*)(gb + 384 + 2 * lane) = (f32x2){__expf(a0 - Mlast), __expf(a1 - Mlast)};
    const float mnext = blast + Mlast;
    if (lane == 0) { sc[0] = mchunk; sc[1] = mnext; }
    return mnext;
}
#define ML_EP(i, j) (32 * ((i) >> 1) + 8 * ((j) >> 2) + 4 * ((i) & 1) + ((j) & 3))
template <int TT> __device__ __forceinline__ void mlstm_unit(Frame& F, int path, int b, int h, int dir, int eh) {
    const int T = path ? 2048 : 256, nc = T / 128, seqbase = path ? NCTX + b * 2048 : b * 256;
    constexpr int w = TT < 4 ? TT : 11 - TT, tt = TT;
    const int lane = fresh_lane(), tid = w * 64 + lane, lr = lane & 15, lq = lane >> 4, q4 = lr >> 2, p4 = lr & 3;
    const int sidx = ((b * 2 + dir) * NH + h);
    const float* GATES = F_GATES; const bf16* PROJ = F_PROJ;
    f32x4 accC[5];
#pragma unroll
    for (int i = 0; i < 5; ++i) accC[i] = (f32x4){0.f, 0.f, 0.f, 0.f};
    float m0 = 0.f;
    if (path) {
        const float* C0 = F_stC + (size_t)sidx * DH * DH;
#pragma unroll
        for (int i = 0; i < 4; ++i)
#pragma unroll
            for (int r = 0; r < 4; ++r) accC[i][r] = C0[(size_t)(16 * w + 4 * lq + r) * DH + 64 * eh + ML_EP(i, lr)];
        if (lr == 0) {
#pragma unroll
            for (int r = 0; r < 4; ++r) accC[4][r] = F_stN[(size_t)sidx * DH + 16 * w + 4 * lq + r]; }
        m0 = F_stM[sidx];
    }
    const int gi_col = (dir ? 16 : 0) + h, gf_col = (dir ? 24 : 8) + h;
    const float bias_i = F_gate_bias[gi_col], bias_f = F_gate_bias[gf_col];
    float mchain = m0;
    if (w == 0) { const GatePre g = gate_load(GATES, seqbase, T, dir, 0, lane, gi_col, gf_col);
        mchain = gate_finish(g, bias_i, bias_f, mchain, (LAS float*)(F.lds + ML_G), (LAS float*)(F.lds + ML_SC), lane); }
    { LAS bf16* CT = (LAS bf16*)(F.lds + ML_CT);
#pragma unroll
        for (int i = 0; i < 5; ++i) if (i < 4 || lr == 0) { v2u o; o.x = pk2(accC[i][0], accC[i][1]); o.y = pk2(accC[i][2], accC[i][3]); *(LAS v2u*)(CT + (16 * i + lr) * KLD + 16 * w + 4 * lq) = o; } }
    constexpr bool LDR = (w < 4); constexpr int NKL = LDR ? 8 : 0, NVL = LDR ? 4 : 0;
    const int krow = (tid & 255) >> 4, kch = tid & 15, vrow = (tid & 255) >> 3, vch = tid & 7;
    v4u kv[8], vv[4]; bf16x8 bq[4], bqn[4]; v4u hold[2];
#pragma unroll
    for (int i = 0; i < 4; ++i) { bqn[i] = (bf16x8){0, 0, 0, 0, 0, 0, 0, 0}; hold[i >> 1] = (v4u){0u, 0u, 0u, 0u}; }
    {
#pragma unroll
        for (int i = 0; i < NKL; ++i) { const int s = krow + 16 * i, stok = dir ? T - 1 - s : s; kv[i] = *(const GAS v4u*)(PROJ + (size_t)(seqbase + stok) * PROJ_LD + 1024 + h * DH + kch * 8); }
#pragma unroll
        for (int i = 0; i < NVL; ++i) { const int s = vrow + 32 * i, stok = dir ? T - 1 - s : s; vv[i] = *(const GAS v4u*)(PROJ + (size_t)(seqbase + stok) * PROJ_LD + 2048 + h * DH + 64 * eh + vch * 8); }
        const int qtok = dir ? T - 1 - (16 * tt + lr) : 16 * tt + lr; const bf16* qrow = PROJ + (size_t)(seqbase + qtok) * PROJ_LD + h * DH + 8 * lq;
#pragma unroll
        for (int kk = 0; kk < 4; ++kk) bq[kk] = *(const GAS bf16x8*)(qrow + 32 * kk); }
    if constexpr (LDR) asm volatile("" :: "v"(kv[0]), "v"(kv[1]), "v"(kv[2]), "v"(kv[3]), "v"(kv[4]), "v"(kv[5]), "v"(kv[6]), "v"(kv[7]), "v"(vv[0]), "v"(vv[1]), "v"(vv[2]), "v"(vv[3]));
    asm volatile("" :: "v"(bq[0]), "v"(bq[1]), "v"(bq[2]), "v"(bq[3]));
    const bf16x8 ones = (lr == 0) ? (bf16x8){0x3F80, 0x3F80, 0x3F80, 0x3F80, 0x3F80, 0x3F80, 0x3F80, 0x3F80} : (bf16x8){0, 0, 0, 0, 0, 0, 0, 0};
    for (int c = 0; c < nc; ++c) {
        const int buf = c & 1;
        LAS bf16* Kb = (LAS bf16*)(F.lds + ML_KB + buf * ML_KB_SZ); LAS bf16* Vb = (LAS bf16*)(F.lds + ML_VB + buf * ML_VB_SZ);
        const LAS bf16* CTb = (const LAS bf16*)(F.lds + ML_CT + buf * ML_CT_SZ);
        const LAS float* gb = (const LAS float*)(F.lds + ML_G + buf * ML_G_SZ); const LAS float* sc = (const LAS float*)(F.lds + ML_SC + buf * 16);
#pragma unroll
        for (int i = 0; i < NKL; ++i) *(LAS v4u*)(Kb + (krow + 16 * i) * KLD + kch * 8) = kv[i];
#pragma unroll
        for (int i = 0; i < NVL; ++i) { LAS bf16* vd = Vb + (vrow + 32 * i) * VLD + 32 * (vch >> 2) + 4 * (vch & 3);
            *(LAS v2u*)vd = (v2u){vv[i].x, vv[i].y}; *(LAS v2u*)(vd + 16) = (v2u){vv[i].z, vv[i].w}; }
        __syncthreads();
        const bool more = (c + 1 < nc);
        const int t = 16 * tt + lr;
        const int cn = more ? c + 1 : c, cp = c > 0 ? c - 1 : 0;
        GatePre gpre; gpre.gi0 = 0.f; gpre.gi1 = 0.f; gpre.gf0 = 0.f; gpre.gf1 = 0.f;
        if (w == 0) gpre = gate_load(GATES, seqbase, T, dir, cn, lane, gi_col, gf_col);
#define ML_VM_ST do { const int tok = dir ? T - 1 - (cp * 128 + t) : cp * 128 + t; bf16* hp = F_HDIR + ((size_t)dir * NTOK + seqbase + tok) * MW + h * DH + 64 * eh + 8 * lq; \
            *(GAS v4u*)hp = hold[0]; *(GAS v4u*)(hp + 32) = hold[1]; } while (0)
#define ML_VM_K(i0) do { if constexpr (LDR) { _Pragma("unroll") for (int i = (i0); i < (i0) + 2; ++i) { const int s = cn * 128 + krow + 16 * i, stok = dir ? T - 1 - s : s; \
            kv[i] = *(const GAS v4u*)(PROJ + (size_t)(seqbase + stok) * PROJ_LD + 1024 + h * DH + kch * 8); } } } while (0)
#define ML_VM_V(i0) do { if constexpr (LDR) { _Pragma("unroll") for (int i = (i0); i < (i0) + 2; ++i) { const int s = cn * 128 + vrow + 32 * i, stok = dir ? T - 1 - s : s; \
            vv[i] = *(const GAS v4u*)(PROJ + (size_t)(seqbase + stok) * PROJ_LD + 2048 + h * DH + 64 * eh + vch * 8); } } } while (0)
#define ML_VM_Q(k0) do { const int qtok = dir ? T - 1 - (cn * 128 + t) : cn * 128 + t; const bf16* qrow = PROJ + (size_t)(seqbase + qtok) * PROJ_LD + h * DH + 8 * lq; \
            _Pragma("unroll") for (int kk = (k0); kk < (k0) + 2; ++kk) bqn[kk] = *(const GAS bf16x8*)(qrow + 32 * kk); } while (0)
        const float Mt = gb[128 + t], mt = gb[256 + t], Mlast = gb[128 + 127], mcur = sc[0];
#define ML_SB __builtin_amdgcn_sched_barrier(0)
#define ML_LOADK(dst, kk) do { _Pragma("unroll") for (int si = 0; si < 8; ++si) if (si <= tt) dst[si] = *(const LAS bf16x8*)(Kb + (16 * si + lr) * KLD + 32 * (kk) + 8 * lq); } while (0)
#define ML_MMAK(src, kk) do { _Pragma("unroll") for (int si = 0; si < 8; ++si) if (si <= tt) st[si] = __builtin_amdgcn_mfma_f32_16x16x32_bf16(src[si], bq[kk], st[si], 0, 0, 0); } while (0)
#define ML_LOADC(dst, kk) do { _Pragma("unroll") for (int i = 0; i < 5; ++i) dst[i] = *(const LAS bf16x8*)(CTb + (16 * i + lr) * KLD + 32 * (kk) + 8 * lq); } while (0)
#define ML_MMAC(src, kk) do { _Pragma("unroll") for (int i = 0; i < 5; ++i) nm[i] = __builtin_amdgcn_mfma_f32_16x16x32_bf16(src[i], bq[kk], nm[i], 0, 0, 0); } while (0)
#define ML_LOADV(vf, ak, wa, wb, kk) do { _Pragma("unroll") for (int i = 0; i < 4; ++i) vf[i] = tr_pair(Vb + (32 * (kk) + 4 * lq + q4) * VLD + 16 * i + 4 * p4, VLD); \
            ak = tr_pair(Kb + (32 * (kk) + 4 * lq + q4) * KLD + 16 * w + 4 * p4, KLD); \
            wa = *(const LAS f32x4*)(gb + 384 + 32 * (kk) + 4 * lq); wb = *(const LAS f32x4*)(gb + 384 + 32 * (kk) + 16 + 4 * lq); } while (0)
#define ML_KSTEP(vf, ak, wa, wb, kk) do { \
            if (2 * (kk) <= tt) { \
                _Pragma("unroll") for (int i = 0; i < 4; ++i) nm[i] = __builtin_amdgcn_mfma_f32_16x16x32_bf16(vf[i], bp[kk], nm[i], 0, 0, 0); \
                nm[4] = __builtin_amdgcn_mfma_f32_16x16x32_bf16(ones, bp[kk], nm[4], 0, 0, 0); } \
            const v4u ar = __builtin_bit_cast(v4u, ak); \
            const v4u aw = (v4u){pk2(bflo(ar[0]) * wa[0], bfhi(ar[0]) * wa[1]), pk2(bflo(ar[1]) * wa[2], bfhi(ar[1]) * wa[3]), pk2(bflo(ar[2]) * wb[0], bfhi(ar[2]) * wb[1]), pk2(bflo(ar[3]) * wb[2], bfhi(ar[3]) * wb[3])}; \
            const bf16x8 akw = __builtin_bit_cast(bf16x8, aw); \
            _Pragma("unroll") for (int i = 0; i < 4; ++i) accC[i] = __builtin_amdgcn_mfma_f32_16x16x32_bf16(akw, vf[i], accC[i], 0, 0, 0); \
            accC[4] = __builtin_amdgcn_mfma_f32_16x16x32_bf16(akw, ones, accC[4], 0, 0, 0); } while (0)
        f32x4 st[8], nm[5];
#pragma unroll
        for (int si = 0; si < 8; ++si) st[si] = (f32x4){0.f, 0.f, 0.f, 0.f};
#pragma unroll
        for (int i = 0; i < 5; ++i) nm[i] = (f32x4){0.f, 0.f, 0.f, 0.f};
        bf16x8 va[4], vb[4], aka, akb; f32x4 waa, wba, wab, wbb; f32x4 av[8];
        {
            bf16x8 fa[8], fb[8];
            ML_LOADK(fa, 0); ML_SB; ML_LOADK(fb, 1); ML_SB; ML_MMAK(fa, 0); ML_VM_K(0); ML_SB; ML_LOADK(fa, 2); ML_SB; ML_MMAK(fb, 1); ML_VM_K(2); ML_SB; ML_LOADK(fb, 3); ML_SB; ML_MMAK(fa, 2); ML_VM_K(4); ML_SB;
            ML_LOADC(fa, 0); ML_SB; ML_MMAK(fb, 3); ML_VM_K(6); ML_SB; ML_LOADC(fb, 1); ML_SB; ML_MMAC(fa, 0); ML_VM_V(0); ML_VM_Q(0); ML_SB; ML_LOADC(fa, 2); ML_SB; ML_MMAC(fb, 1); ML_VM_V(2); ML_VM_Q(2); ML_SB; ML_LOADC(fb, 3); ML_SB; ML_MMAC(fa, 2); ML_VM_ST; ML_SB;
            ML_LOADV(va, aka, waa, wba, 0);
#pragma unroll
            for (int si = 0; si < 8; ++si) if (si <= tt) av[si] = *(const LAS f32x4*)(gb + 16 * si + 4 * lq);
            ML_SB; ML_MMAC(fb, 3); ML_SB;
        }
        const float gt = __expf(mcur - Mt), gs = __expf(mcur - Mlast);
#pragma unroll
        for (int i = 0; i < 5; ++i) { nm[i] = nm[i] * gt; accC[i] = accC[i] * gs; }
        const float Mt2 = Mt * 1.44269504089f;
#pragma unroll
        for (int si = 0; si < 8; ++si) if (si <= tt) {
#pragma unroll
            for (int r = 0; r < 4; ++r) { const float p = st[si][r] * __builtin_amdgcn_exp2f(av[si][r] - Mt2); st[si][r] = (si < tt || 4 * lq + r <= lr) ? p : 0.f; } }
        bf16x8 bp[4];
#pragma unroll
        for (int kk = 0; kk < 4; ++kk) { const v4u pw = (v4u){pk2(st[2 * kk][0], st[2 * kk][1]), pk2(st[2 * kk][2], st[2 * kk][3]), pk2(st[2 * kk + 1][0], st[2 * kk + 1][1]), pk2(st[2 * kk + 1][2], st[2 * kk + 1][3])};
            bp[kk] = __builtin_bit_cast(bf16x8, pw); }
        ML_SB; ML_LOADV(vb, akb, wab, wbb, 1); ML_SB; ML_KSTEP(va, aka, waa, wba, 0); ML_SB;
        ML_LOADV(va, aka, waa, wba, 2); ML_SB; ML_KSTEP(vb, akb, wab, wbb, 1); ML_SB;
        ML_LOADV(vb, akb, wab, wbb, 3); ML_SB; ML_KSTEP(va, aka, waa, wba, 2); ML_SB;
        ML_KSTEP(vb, akb, wab, wbb, 3); ML_SB;
#undef ML_SB
#undef ML_VM_ST
#undef ML_VM_K
#undef ML_VM_V
#undef ML_VM_Q
#undef ML_LOADK
#undef ML_MMAK
#undef ML_LOADC
#undef ML_MMAC
#undef ML_LOADV
#undef ML_KSTEP
        const float den = __shfl(nm[4][0], lr);
        const float inv = 1.f / fmaxf(fabsf(den), __expf(-mt));
#pragma unroll
        for (int a = 0; a < 2; ++a) hold[a] = (v4u){pk2(nm[2 * a][0] * inv, nm[2 * a][1] * inv), pk2(nm[2 * a][2] * inv, nm[2 * a][3] * inv), pk2(nm[2 * a + 1][0] * inv, nm[2 * a + 1][1] * inv), pk2(nm[2 * a + 1][2] * inv, nm[2 * a + 1][3] * inv)};
        { LAS bf16* CTn = (LAS bf16*)(F.lds + ML_CT + (buf ^ 1) * ML_CT_SZ);
#pragma unroll
            for (int i = 0; i < 5; ++i) if (i < 4 || lr == 0) { v2u o; o.x = pk2(accC[i][0], accC[i][1]); o.y = pk2(accC[i][2], accC[i][3]); *(LAS v2u*)(CTn + (16 * i + lr) * KLD + 16 * w + 4 * lq) = o; } }
        if (more && w == 0) mchain = gate_finish(gpre, bias_i, bias_f, mchain, (LAS float*)(F.lds + ML_G + (buf ^ 1) * ML_G_SZ), (LAS float*)(F.lds + ML_SC + (buf ^ 1) * 16), lane);
#pragma unroll
        for (int kk = 0; kk < 4; ++kk) bq[kk] = bqn[kk];
    }
    { const int t = 16 * tt + lr, tok = dir ? T - 1 - ((nc - 1) * 128 + t) : (nc - 1) * 128 + t;
        bf16* hp = F_HDIR + ((size_t)dir * NTOK + seqbase + tok) * MW + h * DH + 64 * eh + 8 * lq;
        *(GAS v4u*)hp = hold[0]; *(GAS v4u*)(hp + 32) = hold[1]; }
    if (!path) {
        const int l2 = fresh_lane(), lr2 = l2 & 15, lq2 = l2 >> 4;
        float* oC = F_out + (size_t)NTOK * D + (size_t)sidx * DH * DH;
#pragma unroll
        for (int i = 0; i < 4; ++i)
#pragma unroll
            for (int r = 0; r < 4; ++r) oC[(size_t)(16 * w + 4 * lq2 + r) * DH + 64 * eh + ML_EP(i, lr2)] = accC[i][r];
        if (eh == 0) {
            float* oN = F_out + (size_t)NTOK * D + (size_t)16 * 2 * NH * DH * DH + (size_t)sidx * DH;
            if (lr2 == 0) {
#pragma unroll
                for (int r = 0; r < 4; ++r) oN[16 * w + 4 * lq2 + r] = accC[4][r]; }
            if (w == 0 && l2 == 0) F_out[(size_t)NTOK * D + (size_t)16 * 2 * NH * DH * DH + (size_t)16 * 2 * NH * DH + sidx] = mchain;
        }
    }
    __syncthreads();
}
__device__ __forceinline__ void p3_mlstm(Frame& F) {
    for (int u = F.vcu; u < 768; u += F.G) {
        const int path = u < 256 ? 1 : 0, id = path ? u : u - 256, b = id >> 5, h = (id >> 2) & 7, dir = (id >> 1) & 1, eh = id & 1;
        switch (F.wave) {
            case 0: mlstm_unit<0>(F, path, b, h, dir, eh); break;
            case 1: mlstm_unit<1>(F, path, b, h, dir, eh); break;
            case 2: mlstm_unit<2>(F, path, b, h, dir, eh); break;
            case 3: mlstm_unit<3>(F, path, b, h, dir, eh); break;
            case 4: mlstm_unit<7>(F, path, b, h, dir, eh); break;
            case 5: mlstm_unit<6>(F, path, b, h, dir, eh); break;
            case 6: mlstm_unit<5>(F, path, b, h, dir, eh); break;
            default: mlstm_unit<4>(F, path, b, h, dir, eh); break;
        }
    }
}
constexpr float HMIX_SCALE = 16.f;
__device__ __forceinline__ void p4_combine(Frame& F) {
    const int lane = fresh_lane();
    const int c0 = 16 * lane;
    const int bx = blockIdx.x; int r_lo, r_hi;
    { const int rp = (NTOK + F.G - 1) / F.G; r_lo = min(NTOK, bx * rp); r_hi = min(NTOK, r_lo + rp); }
    float wn[16];
#pragma unroll
    for (int j = 0; j < 16; ++j) wn[j] = F_mnw[c0 + j] * HMIX_SCALE;
    for (int m0 = r_lo + F.wave; m0 < r_hi; m0 += 2 * NWAVES) {
        v4u a[2][2], bb[2][2], o[2][2];
#pragma unroll
        for (int q = 0; q < 2; ++q) { const int m = min(m0 + NWAVES * q, r_hi - 1);
            const GAS v4u* pf = (const GAS v4u*)(F_HDIR + (size_t)m * MW + c0);
            const GAS v4u* pb = (const GAS v4u*)(F_HDIR + ((size_t)NTOK + m) * MW + c0);
            const GAS v4u* po = (const GAS v4u*)(F_PROJ + (size_t)m * PROJ_LD + 3072 + c0);
#pragma unroll
            for (int i = 0; i < 2; ++i) { a[q][i] = pf[i]; bb[q][i] = pb[i]; o[q][i] = po[i]; } }
#pragma unroll
        for (int q = 0; q < 2; ++q) { const int m = m0 + NWAVES * q;
            float hv[16], ov[16]; float ss = 0.f;
#pragma unroll
            for (int i = 0; i < 2; ++i) {
#pragma unroll
                for (int j = 0; j < 4; ++j) { const float x0 = bflo(a[q][i][j]) + bflo(bb[q][i][j]), x1 = bfhi(a[q][i][j]) + bfhi(bb[q][i][j]); hv[8 * i + 2 * j] = x0; hv[8 * i + 2 * j + 1] = x1; ss += x0 * x0 + x1 * x1;
                    ov[8 * i + 2 * j] = bflo(o[q][i][j]); ov[8 * i + 2 * j + 1] = bfhi(o[q][i][j]); } }
            ss += __shfl_xor(ss, 1); ss += __shfl_xor(ss, 2); ss += __shfl_xor(ss, 4);
            const float rstd = rsqrtf(ss * (1.f / DH) + EPS);
            float yv[16];
#pragma unroll
            for (int j = 0; j < 16; ++j) { const float y = hv[j] * rstd * wn[j] / (1.f + __expf(-ov[j])); yv[j] = fminf(fmaxf(y, -448.f), 448.f); }
            int ow[4];
#pragma unroll
            for (int j = 0; j < 4; ++j) { const int w = __builtin_amdgcn_cvt_pk_fp8_f32(yv[4 * j], yv[4 * j + 1], 0, false); ow[j] = __builtin_amdgcn_cvt_pk_fp8_f32(yv[4 * j + 2], yv[4 * j + 3], w, true); }
            if (m < r_hi) *(GAS v4u*)((unsigned char*)F_RB + (size_t)m * D + c0) = (v4u){(unsigned)ow[0], (unsigned)ow[1], (unsigned)ow[2], (unsigned)ow[3]};
        }
    }
}
template <int WIN> __device__ __forceinline__ void pool_rows(const bf16* ub, unsigned char* pb, int ldo, int rbase, int L) {
    constexpr int HALFW = WIN / 2, NR = 16 + WIN;
#pragma unroll 1
    for (int rb = 0; rb < 4; ++rb) {
        const int r0 = rbase + 16 * rb, seg0 = (r0 / L) * L, tp0 = r0 - seg0;
        v2u x[NR];
#pragma unroll
        for (int i = 0; i < NR; ++i) { const int tp = tp0 - HALFW + i; const int tc = min(max(tp, 0), L - 1); x[i] = *(const GAS v2u*)(ub + (size_t)(seg0 + tc) * PROJ_LD); }
        float s0 = 0.f, s1 = 0.f, s2 = 0.f, s3 = 0.f;
#pragma unroll
        for (int q = 0; q < WIN; ++q) { const int tq = tp0 - HALFW + q; const float ok = (tq >= 0 && tq < L) ? 1.f : 0.f; s0 += ok * bflo(x[q].x); s1 += ok * bfhi(x[q].x); s2 += ok * bflo(x[q].y); s3 += ok * bfhi(x[q].y); }
#pragma unroll
        for (int i = 0; i < 16; ++i) { const int tp = tp0 + i;
            if (i > 0) { const int te = tp + HALFW - 1, tl = tp - HALFW - 1; const float oke = (te < L) ? 1.f : 0.f, okl = (tl >= 0) ? 1.f : 0.f; const v2u e = x[i + WIN - 1], l = x[i - 1];
                s0 += oke * bflo(e.x) - okl * bflo(l.x); s1 += oke * bfhi(e.x) - okl * bfhi(l.x); s2 += oke * bflo(e.y) - okl * bflo(l.y); s3 += oke * bfhi(e.y) - okl * bfhi(l.y); }
            const int lo = max(tp - HALFW, 0), hi = min(tp + HALFW, L); const float inv = 1.f / (float)(hi - lo); const v2u c = x[i + HALFW];
            const float y0 = (s0 * inv - bflo(c.x)) * HMIX_SCALE, y1 = (s1 * inv - bfhi(c.x)) * HMIX_SCALE, y2 = (s2 * inv - bflo(c.y)) * HMIX_SCALE, y3 = (s3 * inv - bfhi(c.y)) * HMIX_SCALE;
            int w = __builtin_amdgcn_cvt_pk_fp8_f32(fminf(fmaxf(y0, -448.f), 448.f), fminf(fmaxf(y1, -448.f), 448.f), 0, false);
            w = __builtin_amdgcn_cvt_pk_fp8_f32(fminf(fmaxf(y2, -448.f), 448.f), fminf(fmaxf(y3, -448.f), 448.f), w, true);
            *(GAS unsigned*)(pb + (size_t)(r0 + i) * ldo) = (unsigned)w; }
    }
}
__device__ __forceinline__ void p4_pool_item(Frame& F, int it) {
    const int rblk = it >> 2, g = it & 3, pm = rblk >> 2, rbase = 64 * (rblk & 3), lane = fresh_lane();
    const int L = pm < 16 ? 256 : 64;
    const bf16* ub = F_PROJ + (size_t)pm * 256 * PROJ_LD + 4096 + 256 * g + 4 * lane;
    unsigned char* pb = (unsigned char*)F_RB + (size_t)pm * 256 * D + 1024 + 256 * g + 4 * lane;
    if (g == 0) pool_rows<2>(ub, pb, D, rbase, L); else if (g == 1) pool_rows<4>(ub, pb, D, rbase, L); else if (g == 2) pool_rows<8>(ub, pb, D, rbase, L); else pool_rows<16>(ub, pb, D, rbase, L);
}
__device__ __forceinline__ f32x4 bf4(v2u w) { return (f32x4){bflo(w.x), bfhi(w.x), bflo(w.y), bfhi(w.y)}; }
__device__ __forceinline__ float sq4(f32x4 v) { return (v.x * v.x + v.y * v.y) + (v.z * v.z + v.w * v.w); }
__device__ __forceinline__ void p6_norm(Frame& F) {
    const int lane = fresh_lane();
    const bf16* MIX = F_HDIR; const bf16* MIX1 = F_MIX1;
    LAS f32x4* pA = (LAS f32x4*)(F.lds); LAS f32x4* pB = pA + D / 4; LAS f32x4* pC = pB + D / 4;
    const int rpw = (NTOK + F.G - 1) / F.G, r_lo = F.vcu * rpw, r_hi = min(NTOK, r_lo + rpw);
    int cur = r_lo; RowSeg sg;
    while (next_seg(cur, r_hi, sg)) {
        const float* mod = F_MOD + (size_t)sg.mr * 12288;
        for (int i = F.tid; i < D / 4; i += NWAVES * 64) { const f32x4 w1 = *(const f32x4*)(F_norm_w + D + 4 * i), ga = *(const f32x4*)(mod + 2 * D + 4 * i), w2 = *(const f32x4*)(F_norm_w + 2 * D + 4 * i), sc = *(const f32x4*)(mod + 4 * D + 4 * i);
            pA[i] = ga * w1; pB[i] = w2 * (sc + 1.f); pC[i] = *(const f32x4*)(mod + 3 * D + 4 * i); }
        __syncthreads();
        for (int m = sg.lo + F.wave; m < sg.hi; m += NWAVES) {
            f32x4 v[8]; v2u mm[8];
            { const GAS f32x4* xr = (const GAS f32x4*)xrow_ptr(F, m) + lane; const GAS v2u* mr = (const GAS v2u*)(MIX + (size_t)m * D) + lane;
#pragma unroll
                for (int j = 0; j < 8; ++j) { v[j] = __builtin_nontemporal_load(xr + 64 * j); mm[j] = __builtin_nontemporal_load(mr + 64 * j); } }
            f32x4 mx[8]; float sq = 0.f;
#pragma unroll
            for (int j = 0; j < 8; ++j) mx[j] = bf4(mm[j]);
            if (m >= TAIL_PM0 * 256) { const GAS v2u* m1 = (const GAS v2u*)(MIX1 + (size_t)(m - TAIL_PM0 * 256) * D) + lane;
#pragma unroll
                for (int j = 0; j < 8; ++j) mx[j] = mx[j] + bf4(m1[64 * j]); }
#pragma unroll
            for (int j = 0; j < 8; ++j) sq += sq4(mx[j]);
            const float rstd1 = rsqrtf(wave_sum(sq) * (1.f / D) + EPS);
            float s = 0.f;
#pragma unroll
            for (int j = 0; j < 8; ++j) { v[j] = v[j] + pA[lane + 64 * j] * (mx[j] * rstd1); s += sq4(v[j]); }
            const float rstd2 = rsqrtf(wave_sum(s) * (1.f / D) + EPS);
            GAS v2u* xrow = (GAS v2u*)(F_out + (size_t)m * D) + lane;
            GAS unsigned* o8 = (GAS unsigned*)((unsigned char*)F_RB + (size_t)m * D) + lane;
#pragma unroll
            for (int j = 0; j < 8; ++j) { v2u xo; xo.x = pk2(v[j].x, v[j].y); xo.y = pk2(v[j].z, v[j].w); xrow[64 * j] = xo;
                const f32x4 h = (v[j] * rstd2 * pB[lane + 64 * j] + pC[lane + 64 * j]) * H2_SCALE;
                int w = __builtin_amdgcn_cvt_pk_fp8_f32(fminf(fmaxf(h.x, -448.f), 448.f), fminf(fmaxf(h.y, -448.f), 448.f), 0, false);
                w = __builtin_amdgcn_cvt_pk_fp8_f32(fminf(fmaxf(h.z, -448.f), 448.f), fminf(fmaxf(h.w, -448.f), 448.f), w, true); o8[64 * j] = (unsigned)w; }
        }
        __syncthreads();
    }
}
__device__ __forceinline__ void p9_final(Frame& F) {
    const int lane = fresh_lane();
    const bf16* Y1 = F_Y1;
    LAS f32x4* pA = (LAS f32x4*)(F.lds);
    const int rpw = (NTOK + F.G - 1) / F.G, r_lo = F.vcu * rpw, r_hi = min(NTOK, r_lo + rpw);
    int cur = r_lo; RowSeg sg;
    while (next_seg(cur, r_hi, sg)) {
        const float* mod = F_MOD + (size_t)sg.mr * 12288;
        for (int i = F.tid; i < D / 4; i += NWAVES * 64) pA[i] = *(const f32x4*)(mod + 5 * D + 4 * i) * *(const f32x4*)(F_norm_w + 3 * D + 4 * i);
        __syncthreads();
        for (int mb = sg.lo + 2 * F.wave; mb < sg.hi; mb += 2 * NWAVES) {
            v2u xx[2][8]; v2u yy[2][8];
#pragma unroll
            for (int q = 0; q < 2; ++q) { const int m = min(mb + q, sg.hi - 1);
                const GAS v2u* xr = (const GAS v2u*)(F_out + (size_t)m * D) + lane; const GAS v2u* yr = (const GAS v2u*)(F_RB + (size_t)m * D) + lane;
#pragma unroll
                for (int j = 0; j < 8; ++j) { xx[q][j] = __builtin_nontemporal_load(xr + 64 * j); yy[q][j] = __builtin_nontemporal_load(yr + 64 * j); } }
#pragma unroll
            for (int q = 0; q < 2; ++q) { const int m = min(mb + q, sg.hi - 1);
                f32x4 yv[8]; float sq = 0.f;
#pragma unroll
                for (int j = 0; j < 8; ++j) yv[j] = bf4(yy[q][j]);
                if (m >= TAIL_PM0 * 256) { const GAS v2u* y1 = (const GAS v2u*)(Y1 + (size_t)(m - TAIL_PM0 * 256) * D) + lane;
#pragma unroll
                    for (int j = 0; j < 8; ++j) yv[j] = yv[j] + bf4(y1[64 * j]); }
#pragma unroll
                for (int j = 0; j < 8; ++j) sq += sq4(yv[j]);
                const float rstd = rsqrtf(wave_sum(sq) * (1.f / D) + EPS);
                if (mb + q < sg.hi) {
                    GAS f32x4* orow = (GAS f32x4*)(F_out + (size_t)m * D) + lane;
#pragma unroll
                    for (int j = 0; j < 8; ++j) orow[64 * j] = bf4(xx[q][j]) + pA[lane + 64 * j] * (yv[j] * rstd); } }
        }
        __syncthreads();
    }
}

__global__ void __launch_bounds__(NWAVES * 64, 2) hymba_fwd(Args args) {
    extern __shared__ __attribute__((aligned(16))) unsigned char lds[];
    Frame F;
    F.lds = (LAS unsigned char*)lds;
    F.MISC = (volatile LAS unsigned*)(F.lds + MISC_OFF);
    F.tid = threadIdx.x; F.lane = F.tid & 63; F.wave = __builtin_amdgcn_readfirstlane(F.tid >> 6);
    F.G = gridDim.x; { const int bx = blockIdx.x; F.vcu = (F.G % 8 == 0) ? (bx % 8) * (F.G / 8) + bx / 8 : bx; }
    F.a = &args;
    for (int u = F.tid; u < (LDS_BYTES - LDSCTL_OFF) / 4; u += NWAVES * 64) ((LAS unsigned*)(F.lds + LDSCTL_OFF))[u] = 0u;
    __syncthreads();
    XcdBarrier bar; bar.bar = (unsigned*)(F_ctl + CW_BAR); bar.x = 0; bar.st = nullptr;
    if (N_LAUNCHES != PER_PHASE) bar = xcd_barrier_post((unsigned*)(F_ctl + CW_BAR) + args.li * XCD_BAR_WORDS, F.MISC + 8);
#define GRID_BAR(seam) do { if (N_LAUNCHES == PER_PHASE) { if (F.tid == 0) __hip_atomic_store(F_ctl + CW_TMO, 0xBADBA0u | (unsigned)(seam), RLX_AGENT); } else { xcd_barrier(bar); } } while (0)
    const int lo = args.ph_lo, hi = args.ph_hi;
#ifndef PH_MASK
#define PH_MASK 0x3ff
#endif
#ifndef REP_MASK
#define REP_MASK 0
#endif
#define REPS(k) ((((REP_MASK) >> (k)) & 1) ? 2 : 1)
#define IN(k) ((((PH_MASK) >> (k)) & 1) && lo <= (k) && (k) < hi)
#define BOTH(k) (IN(k) && IN((k) + 1))

    if (IN(0)) { for (int rep = 0; rep < REPS(0); ++rep) { p0_mod_gemv(F); p0_transposes(F, 0, F.vcu, F.G); if (BOTH(0)) GRID_BAR(0); } }
    if (IN(1)) { for (int rep = 0; rep < REPS(1); ++rep) { p1_h1(F); if (BOTH(1)) GRID_BAR(1); } }
    if (IN(2)) {
        pg8::Gemm g{F_RB, F_WinT, D, D, D, 0x7F7F7F7Fu}; pg8::StaticOrder S; S.init(NTOK, WIN_ROWS, F.G, (int)blockIdx.x);
        pg8::EpiProj E{F_PROJ, F_GATES, NTOK};
        pg8::gemm_phase<pg8::EpiProj, pg8::StaticOrder, true, true>(F.lds + RING_OFF, g, S, E);
        { const int nun = (NTOK / 256) * (WIN_ROWS / 256), rem = nun % F.G;
          if (rem == 0) p0_transposes(F, 1, (int)blockIdx.x, F.G); else if ((int)blockIdx.x >= rem) p0_transposes(F, 1, (int)blockIdx.x - rem, F.G - rem); }
        if (BOTH(2)) GRID_BAR(2);
    }
    if (IN(3)) { for (int rep = 0; rep < REPS(3); ++rep) { p3_mlstm(F); if (BOTH(3)) GRID_BAR(3); } }
    if (IN(4)) { for (int rep = 0; rep < REPS(4); ++rep) {
        p4_combine(F);
        for (int it = F.wave * F.G + (int)blockIdx.x; it < 1280; it += NWAVES * F.G) p4_pool_item(F, it);
        __syncthreads();
        if (BOTH(4)) GRID_BAR(4); }
    }
    if (IN(5)) {
        { pg8::Gemm g{F_RB, F_WoutT, D, D, D, 0x7A7A7A7Au}; pg8::StaticOrder S; S.init(TAIL_PM0 * 256, D, F.G, (int)blockIdx.x);
          pg8::EpiBf16<0, false, false> E{F_HDIR, D, nullptr, 0, 1.f};
          pg8::gemm_phase<pg8::EpiBf16<0, false, false>, pg8::StaticOrder, true, true, true>(F.lds + RING_OFF, g, S, E); }
        { pg8::Gemm g{F_RB, F_WoutT, D / 2, D, D, 0x7A7A7A7Au}; pg8::SplitTail S{TAIL_PM0, TAIL_NM, D / 2, F.G, (int)blockIdx.x};
          pg8::EpiBf16<0, true, false> E{F_HDIR, D, F_MIX1, TAIL_PM0, 1.f};
          pg8::gemm_phase<pg8::EpiBf16<0, true, false>, pg8::SplitTail, true, true, true>(F.lds + RING_OFF, g, S, E); }
        if (BOTH(5)) GRID_BAR(5);
    }
    if (IN(6)) { for (int rep = 0; rep < REPS(6); ++rep) { p6_norm(F); if (BOTH(6)) GRID_BAR(6); } }
    if (IN(7)) {
        static_assert(W1_SCALE * H2_SCALE == 256.f, "sc8 below is 2^-8");
        pg8::Gemm g{F_RB, F_W1T, D, D, D, 0x7B7B7B7Bu}; pg8::StaticOrder S; S.init(NTOK, FF, F.G, (int)blockIdx.x);
        pg8::EpiF8Relu2 E{(unsigned char*)F_HFF, FF};
        pg8::gemm_phase<pg8::EpiF8Relu2, pg8::StaticOrder, true, true, true>(F.lds + RING_OFF, g, S, E);
        if (BOTH(7)) GRID_BAR(7);
    }
    if (IN(8)) {
        { pg8::Gemm g{F_HFF, F_W2T, FF, FF, FF, 0x7C7C7C7Cu}; pg8::StaticOrder S; S.init(TAIL_PM0 * 256, D, F.G, (int)blockIdx.x);
          pg8::EpiBf16<0, false, false> E{F_RB, D, nullptr, 0, 1.f};
          pg8::gemm_phase<pg8::EpiBf16<0, false, false>, pg8::StaticOrder, true, true, true>(F.lds + RING_OFF, g, S, E); }
        { pg8::Gemm g{F_HFF, F_W2T, FF / 2, FF, FF, 0x7C7C7C7Cu}; pg8::SplitTail S{TAIL_PM0, TAIL_NM, FF / 2, F.G, (int)blockIdx.x};
          pg8::EpiBf16<0, true, false> E{F_RB, D, F_Y1, TAIL_PM0, 1.f};
          pg8::gemm_phase<pg8::EpiBf16<0, true, false>, pg8::SplitTail, true, true, true>(F.lds + RING_OFF, g, S, E); }
        if (BOTH(8)) GRID_BAR(8);
    }
    if (IN(9)) { p9_final(F); }
#undef IN
#undef BOTH
}

extern "C" void kernel_launch(void* const* d_in, const int* in_sizes, int n_in, void* d_out, int out_size, void* d_ws, size_t ws_size, hipStream_t stream) {
    static int grid = 0;
    if (grid == 0) {
        if (n_in != 18 || ws_size < WS_END) { fprintf(stderr, "kernel_launch: built for 18 inputs and >= %zu bytes of workspace; got n_in %d, ws %zu; nothing launched\n", (size_t)WS_END, n_in, ws_size); grid = -1; return; }
        int dev = 0, cus = 0, per_cu = 0;
        if (hipGetDevice(&dev) != hipSuccess || hipDeviceGetAttribute(&cus, hipDeviceAttributeMultiprocessorCount, dev) != hipSuccess) { fprintf(stderr, "kernel_launch: device query failed\n"); grid = -1; return; }
        if (hipFuncSetAttribute((const void*)hymba_fwd, hipFuncAttributeMaxDynamicSharedMemorySize, LDS_BYTES) != hipSuccess) { fprintf(stderr, "kernel_launch: hipFuncSetAttribute failed\n"); grid = -1; return; }
        if (hipOccupancyMaxActiveBlocksPerMultiprocessor(&per_cu, (const void*)hymba_fwd, NWAVES * 64, LDS_BYTES) != hipSuccess || per_cu < 1)
            fprintf(stderr, "kernel_launch: note: occupancy query reports %d workgroups per CU\n", per_cu);
        (void)hipGetLastError();
        grid = cus;
    }
    if (grid < 0) return;
    if (hipMemsetAsync((char*)d_ws + WS_CTL, 0, CTL_ZERO_BYTES, stream) != hipSuccess) { fprintf(stderr, "kernel_launch: hipMemsetAsync failed\n"); return; }
    Args a{};
    for (int i = 0; i < 18; ++i) a.in[i] = (const float*)d_in[i];
    a.out = (float*)d_out; a.ws = (unsigned char*)d_ws;
    if (N_LAUNCHES == 1) {
        a.ph_lo = 0; a.ph_hi = PER_PHASE; a.li = 0;
        hipLaunchKernelGGL(hymba_fwd, dim3(grid), dim3(NWAVES * 64), LDS_BYTES, stream, a);
    } else {
        for (int li = 0; li < PER_PHASE; ++li) { a.ph_lo = li; a.ph_hi = li + 1; a.li = 0;
            hipLaunchKernelGGL(hymba_fwd, dim3(grid), dim3(NWAVES * 64), LDS_BYTES, stream, a); }
    }
    const hipError_t le = hipPeekAtLastError();
    if (le != hipSuccess) fprintf(stderr, "kernel_launch: launch failed: %s\n", hipGetErrorName(le));
}
```

```cpp
#include <hip/hip_runtime.h>
#include <cstdio>
#include <cstdint>

#ifndef MK_N_LAUNCHES
#define MK_N_LAUNCHES 1
#endif

namespace pg8 {
#define PG8_LAS __attribute__((address_space(3)))
typedef unsigned short bf16_t;
typedef short bf16x8 __attribute__((ext_vector_type(8)));
typedef float f32x4 __attribute__((ext_vector_type(4)));
typedef unsigned u32x4 __attribute__((ext_vector_type(4)));
typedef unsigned u32x2 __attribute__((ext_vector_type(2)));
typedef int v8i __attribute__((ext_vector_type(8)));
typedef int v4i __attribute__((ext_vector_type(4)));
typedef short s16x16a __attribute__((ext_vector_type(16), aligned(16)));
constexpr int BM = 256, BK = 64, HALF = 128, HTB = HALF * BK * 2, STAGE_BYTES = 8 * HTB, NXCD = 8, WGM = 8;

__host__ __device__ __forceinline__ int lds_byte(int r, int c) { const int st = (r >> 4) * 2 + (c >> 5), rr = r & 15, cc = c & 31, ob = rr * 64 + cc * 2; return st * 1024 + (ob ^ (((ob >> 9) & 1) << 5)); }
__host__ __device__ __forceinline__ void stage_rc(int b, int& R, int& C) { const int st = b / 1024, sb = b % 1024, swz = sb ^ (((sb >> 9) & 1) << 5); R = (st >> 1) * 16 + swz / 64; C = (st & 1) * 32 + (swz % 64) / 2; }
__host__ __device__ __forceinline__ int perm32(int rho) { const int n = rho >> 4, i = rho & 15; return 8 * (i >> 2) + 4 * n + (i & 3); }

struct Unit { int pm, pn, ka, kb, nk; };
struct Gemm { const bf16_t* A; const bf16_t* Bt; int K, lda, ldb; unsigned sc8; };

struct StaticOrder {
    int nM, nN, nwg, G, c;
    __host__ __device__ void init(int M, int N, int G_, int c_) { nM = M / BM; nN = N / BM; nwg = nM * nN; G = G_; c = c_; }
    __host__ __device__ bool next(int i, Unit& u) const {
        const long L = (long)i * G + c; if (L >= nwg) return false;
        int wgid = (int)L; { const int q = nwg / NXCD, r = nwg % NXCD, xcd = wgid % NXCD, off = wgid / NXCD; wgid = (xcd < r ? xcd * (q + 1) : r * (q + 1) + (xcd - r) * q) + off; }
        const int nig = WGM * nN, gid = wgid / nig, fm = gid * WGM, gsz = (nM - fm) < WGM ? (nM - fm) : WGM;
        u.pm = fm + ((wgid % nig) % gsz); u.pn = (wgid % nig) / gsz; u.ka = 0; u.kb = 0; u.nk = 0; return true;
    }
};
struct SplitTail {
    int pm0, nMt, kh_len, G, c;
    __host__ __device__ bool next(int i, Unit& u) const {
        const int ntile = nMt * 8; const long L = (long)i * G + c; if (L >= 2 * ntile) return false;
        const int kh = (int)L / ntile; int wgid = (int)L % ntile; { const int q = ntile / NXCD, xcd = wgid % NXCD, off = wgid / NXCD; wgid = xcd * q + off; }
        const int nig = WGM * 8, gid = wgid / nig, fm = gid * WGM, gsz = (nMt - fm) < WGM ? (nMt - fm) : WGM;
        u.pm = pm0 + fm + ((wgid % nig) % gsz); u.pn = (wgid % nig) / gsz; u.ka = kh * kh_len; u.kb = kh * kh_len; u.nk = kh_len; return true;
    }
};
struct FullThenSplit {
    static constexpr bool VARK = true;
    StaticOrder full; SplitTail tail; int nfull;
    __host__ __device__ void init(int Mfull, int N, int pm0, int nMt, int kh_len, int G, int c) { full.init(Mfull, N, G, c); tail = SplitTail{pm0, nMt, kh_len, G, c}; nfull = c < full.nwg ? (full.nwg - c + G - 1) / G : 0; }
    __host__ __device__ bool next(int i, Unit& u) const { return i < nfull ? full.next(i, u) : tail.next(i - nfull, u); }
};
struct OneUnit {
    Unit u;
    __host__ __device__ bool next(int i, Unit& o) const { if (i) return false; o = u; o.nk = 0; return true; }
};

typedef __bf16 bf16x2_t __attribute__((ext_vector_type(2)));
__device__ __forceinline__ unsigned cvt_pk_bf16(float lo, float hi) { const bf16x2_t v = {(__bf16)lo, (__bf16)hi}; return __builtin_bit_cast(unsigned, v); }

struct EpiProj {
    static constexpr bool PERM = true;
    bf16_t* P; float* G; int ntok;
    __device__ __forceinline__ void operator()(const f32x4 (&acc)[2][2][4][2], const Unit& u, int wr, int wc, int fr, int fq) const {
        const int row0 = u.pm * BM + wr * 64 + fr;
        if (u.pn < 20) {
            const int col0 = u.pn * BM + wc * 32 + 8 * fq;
#pragma unroll
            for (int ai = 0; ai < 2; ++ai)
#pragma unroll
                for (int m = 0; m < 4; ++m) { bf16_t* rowp = P + (size_t)(row0 + ai * HALF + m * 16) * 5120 + col0;
#pragma unroll
                    for (int bj = 0; bj < 2; ++bj) { const f32x4 v0 = acc[ai][bj][m][0], v1 = acc[ai][bj][m][1];
                        u32x4 w; w.x = cvt_pk_bf16(v0[0], v0[1]); w.y = cvt_pk_bf16(v0[2], v0[3]); w.z = cvt_pk_bf16(v1[0], v1[1]); w.w = cvt_pk_bf16(v1[2], v1[3]);
                        *(u32x4*)(rowp + bj * HALF) = w; } }
        } else if (wc == 0) {
#pragma unroll
            for (int ai = 0; ai < 2; ++ai)
#pragma unroll
                for (int m = 0; m < 4; ++m) { float* gp = G + (size_t)(8 * fq) * ntok + (row0 + ai * HALF + m * 16);
#pragma unroll
                    for (int n = 0; n < 2; ++n)
#pragma unroll
                        for (int j = 0; j < 4; ++j) gp[(size_t)(4 * n + j) * ntok] = acc[ai][0][m][n][j]; }
        }
    }
};
template <int ACT, bool SPLIT, bool SCALE = true> struct EpiBf16 {
    static constexpr bool PERM = true;
    bf16_t* O; int ldc; bf16_t* O2; int pm0; float oscale;
    __device__ __forceinline__ void operator()(const f32x4 (&acc)[2][2][4][2], const Unit& u, int wr, int wc, int fr, int fq) const {
        const int col0 = u.pn * BM + wc * 32 + 8 * fq;
        bf16_t* base = O + (size_t)(u.pm * BM + wr * 64 + fr) * ldc + col0;
        if (SPLIT) { if (u.ka != 0) base = O2 + (size_t)((u.pm - pm0) * BM + wr * 64 + fr) * ldc + col0; }
#pragma unroll
        for (int ai = 0; ai < 2; ++ai)
#pragma unroll
            for (int m = 0; m < 4; ++m) { bf16_t* rowp = base + (size_t)(ai * HALF + m * 16) * ldc;
#pragma unroll
                for (int bj = 0; bj < 2; ++bj) { f32x4 v0 = acc[ai][bj][m][0], v1 = acc[ai][bj][m][1];
                    if (SCALE) { v0 = v0 * oscale; v1 = v1 * oscale; }
                    if (ACT == 1) {
#pragma unroll
                        for (int j = 0; j < 4; ++j) { const float a = fmaxf(v0[j], 0.f), b = fmaxf(v1[j], 0.f); v0[j] = a * a; v1[j] = b * b; } }
                    u32x4 w; w.x = cvt_pk_bf16(v0[0], v0[1]); w.y = cvt_pk_bf16(v0[2], v0[3]); w.z = cvt_pk_bf16(v1[0], v1[1]); w.w = cvt_pk_bf16(v1[2], v1[3]);
                    *(u32x4*)(rowp + bj * HALF) = w; } }
    }
};

struct EpiF8Relu2 {
    static constexpr bool PERM = true;
    unsigned char* O; int ldc;
    __device__ __forceinline__ void operator()(const f32x4 (&acc)[2][2][4][2], const Unit& u, int wr, int wc, int fr, int fq) const {
        unsigned char* base = O + (size_t)(u.pm * BM + wr * 64 + fr) * ldc + u.pn * BM + wc * 64 + 16 * fq;
#pragma unroll
        for (int ai = 0; ai < 2; ++ai)
#pragma unroll
            for (int m = 0; m < 4; ++m) { unsigned w[4];
#pragma unroll
                for (int bj = 0; bj < 2; ++bj) { f32x4 v0 = acc[ai][bj][m][0], v1 = acc[ai][bj][m][1];
#pragma unroll
                    for (int j = 0; j < 4; ++j) { v0[j] = __builtin_amdgcn_fmed3f(v0[j], 0.f, 21.16f); v1[j] = __builtin_amdgcn_fmed3f(v1[j], 0.f, 21.16f); }
                    v0 = v0 * v0; v1 = v1 * v1;
                    int w0 = __builtin_amdgcn_cvt_pk_fp8_f32(v0[0], v0[1], 0, false); w0 = __builtin_amdgcn_cvt_pk_fp8_f32(v0[2], v0[3], w0, true);
                    int w1 = __builtin_amdgcn_cvt_pk_fp8_f32(v1[0], v1[1], 0, false); w1 = __builtin_amdgcn_cvt_pk_fp8_f32(v1[2], v1[3], w1, true);
                    w[2 * bj] = (unsigned)w0; w[2 * bj + 1] = (unsigned)w1; }
                *(u32x4*)(base + (size_t)(ai * HALF + m * 16) * ldc) = (u32x4){w[0], w[1], w[2], w[3]}; }
    }
};

template <class E_> constexpr bool perm16_v = false;
template <> constexpr bool perm16_v<EpiF8Relu2> = true;
template <class Epi, class Sched, bool ALIGN_EPI = false, bool SP2 = false, bool F8 = false>
__device__ __forceinline__ void gemm_phase(PG8_LAS unsigned char* lds, const Gemm g, const Sched& S, const Epi& E) {
    const int tid = threadIdx.x, wid = __builtin_amdgcn_readfirstlane(tid >> 6), lane = tid & 63, wr = wid >> 2, wc = wid & 3, fr = lane & 15, fq = lane >> 4;
    constexpr int ES = F8 ? 1 : 2;
    const int K = g.K; int nt = K * ES / (BK * 2);
    unsigned voffA[2], voffB[2];
#pragma unroll
    for (int i = 0; i < 2; ++i) { int R, C; stage_rc(tid * 16 + i * 8192, R, C);
        const int Rb = perm16_v<Epi> ? (64 * (R >> 5) + 16 * ((R >> 2) & 3) + 4 * ((R >> 4) & 1) + (R & 3)) : (Epi::PERM ? ((R & ~31) + perm32(R & 31)) : R);
        voffA[i] = (unsigned)(R * g.lda * ES + C * 2); voffB[i] = (unsigned)(Rb * g.ldb * ES + C * 2); }
    const size_t kstep = (size_t)(BK * 2);
    const size_t hstepA = (size_t)HALF * g.lda * ES, hstepB = (size_t)(perm16_v<Epi> ? 8 : HALF) * g.ldb * ES;
    const unsigned ldsw = (unsigned)wid * 1024u;
    const int aoff = lds_byte(wr * 64 + fr, fq * 8), boff = lds_byte(wc * 32 + fr, fq * 8);
#define PG8_UA(u) ((const char*)g.A + ((size_t)(u).pm * BM * g.lda + (size_t)(u).ka) * ES)
#define PG8_UB(u) ((const char*)g.Bt + ((size_t)(u).pn * BM * g.ldb + (size_t)(u).kb) * ES)
#define PG8_SA(b, h) (((b) * 2 + (h)) * HTB)
#define PG8_SB(b, h) ((4 + (b) * 2 + (h)) * HTB)
#define PG8_STAGE(bufoff, gbase, voff) do { _Pragma("unroll") for (int _i = 0; _i < 2; ++_i) \
        __builtin_amdgcn_global_load_lds((const unsigned*)((const char*)(gbase) + (voff)[_i]), (PG8_LAS unsigned*)(lds + (bufoff) + ldsw + _i * 8192), 16, 0, 0); } while (0)
#define PG8_LDA(dst, b, h) do { if constexpr (F8) { _Pragma("unroll") for (int m = 0; m < 4; ++m) dst##8[m] = __builtin_shufflevector(*(const PG8_LAS bf16x8*)(lds + PG8_SA(b, h) + aoff + m * 2048), *(const PG8_LAS bf16x8*)(lds + PG8_SA(b, h) + aoff + m * 2048 + 1024), 0, 1, 2, 3, 4, 5, 6, 7, 8, 9, 10, 11, 12, 13, 14, 15); } \
        else { _Pragma("unroll") for (int m = 0; m < 4; ++m) _Pragma("unroll") for (int k = 0; k < 2; ++k) dst[m][k] = *(const PG8_LAS bf16x8*)(lds + PG8_SA(b, h) + aoff + m * 2048 + k * 1024); } } while (0)
#define PG8_LDB(dst, b, h) do { if constexpr (F8) { _Pragma("unroll") for (int n = 0; n < 2; ++n) dst##8[n] = __builtin_shufflevector(*(const PG8_LAS bf16x8*)(lds + PG8_SB(b, h) + boff + n * 2048), *(const PG8_LAS bf16x8*)(lds + PG8_SB(b, h) + boff + n * 2048 + 1024), 0, 1, 2, 3, 4, 5, 6, 7, 8, 9, 10, 11, 12, 13, 14, 15); } \
        else { _Pragma("unroll") for (int n = 0; n < 2; ++n) _Pragma("unroll") for (int k = 0; k < 2; ++k) dst[n][k] = *(const PG8_LAS bf16x8*)(lds + PG8_SB(b, h) + boff + n * 2048 + k * 1024); } } while (0)
#define PG8_MMA(ai, bj, At, Bt) do { __builtin_amdgcn_s_setprio(1); _Pragma("unroll") for (int m = 0; m < 4; ++m) _Pragma("unroll") for (int n = 0; n < 2; ++n) { \
        if constexpr (F8) asm volatile("v_mfma_scale_f32_16x16x128_f8f6f4 %0, %1, %2, %0, %3, %3 op_sel_hi:[0,0,0]" : "+v"(acc[ai][bj][m][n]) : "v"(Bt##8[n]), "v"(At##8[m]), "v"(scv)); \
        else { _Pragma("unroll") for (int k = 0; k < 2; ++k) acc[ai][bj][m][n] = __builtin_amdgcn_mfma_f32_16x16x32_bf16(Bt[n][k], At[m][k], acc[ai][bj][m][n], 0, 0, 0); } } \
        __builtin_amdgcn_s_setprio(0); } while (0)
#define PG8_WAIT_V(n) asm volatile("s_waitcnt vmcnt(" #n ")" ::: "memory")
#define PG8_WAIT_L(n) asm volatile("s_waitcnt lgkmcnt(" #n ")" ::: "memory")
#define PG8_BAR __builtin_amdgcn_s_barrier()
#define PG8_SCHED __builtin_amdgcn_sched_barrier(0)
    Unit cur, nxt; int ui = 0; const unsigned scv = g.sc8;
    if (!S.next(0, cur)) return;
    if (cur.nk) nt = cur.nk * ES / (BK * 2);
    f32x4 acc[2][2][4][2];
#pragma unroll
    for (int a = 0; a < 2; ++a)
#pragma unroll
        for (int b = 0; b < 2; ++b)
#pragma unroll
            for (int m = 0; m < 4; ++m)
#pragma unroll
                for (int n = 0; n < 2; ++n) acc[a][b][m][n] = (f32x4){0.f, 0.f, 0.f, 0.f};
    bf16x8 At[4][2], B0[2][2], B1[2][2]; s16x16a At8[4], B08[2], B18[2];
    const char* cA = PG8_UA(cur); const char* cB = PG8_UB(cur);
    if constexpr (SP2) {
        PG8_STAGE(PG8_SB(0, 0), cB, voffB); PG8_STAGE(PG8_SB(0, 1), cB + hstepB, voffB); PG8_STAGE(PG8_SA(0, 0), cA, voffA); PG8_STAGE(PG8_SA(0, 1), cA + hstepA, voffA);
        if (wr == 1) PG8_BAR;
        PG8_WAIT_V(2); PG8_BAR;
        PG8_STAGE(PG8_SB(1, 0), cB + kstep, voffB); PG8_STAGE(PG8_SA(1, 0), cA + kstep, voffA); PG8_STAGE(PG8_SB(1, 1), cB + hstepB + kstep, voffB);
        PG8_WAIT_V(6); PG8_BAR;
    } else {
        PG8_STAGE(PG8_SB(0, 0), cB, voffB); PG8_STAGE(PG8_SA(0, 0), cA, voffA); PG8_STAGE(PG8_SB(0, 1), cB + hstepB, voffB); PG8_STAGE(PG8_SA(0, 1), cA + hstepA, voffA);
        if (wr == 1) PG8_BAR;
        PG8_WAIT_V(4); PG8_BAR;
        PG8_STAGE(PG8_SB(1, 0), cB + kstep, voffB); PG8_STAGE(PG8_SA(1, 0), cA + kstep, voffA); PG8_STAGE(PG8_SB(1, 1), cB + hstepB + kstep, voffB);
        PG8_WAIT_V(6); PG8_BAR;
    }
    for (;;) {
        const bool has_next = S.next(ui + 1, nxt);
        const char* nA = has_next ? PG8_UA(nxt) : cA; const char* nB = has_next ? PG8_UB(nxt) : cB;
        for (int t = 0; t < nt; t += 2) {
            const bool last = (t == nt - 2);
            const char* a1 = cA + (size_t)(t + 1) * kstep;
            const char* a2 = last ? nA : cA + (size_t)(t + 2) * kstep; const char* b2 = last ? nB : cB + (size_t)(t + 2) * kstep;
            const char* a3 = a2 + kstep; const char* b3 = b2 + kstep;
            if constexpr (SP2) {
            PG8_LDB(B0, 0, 0); PG8_LDB(B1, 0, 1); PG8_SCHED; PG8_LDA(At, 0, 0); PG8_STAGE(PG8_SA(1, 1), a1 + hstepA, voffA);
            PG8_WAIT_V(8); PG8_WAIT_L(0); PG8_BAR; PG8_MMA(0, 0, At, B0); PG8_MMA(0, 1, At, B1); PG8_BAR; PG8_SCHED;
            PG8_LDA(At, 0, 1); PG8_STAGE(PG8_SB(0, 0), b2, voffB); PG8_STAGE(PG8_SB(0, 1), b2 + hstepB, voffB); PG8_STAGE(PG8_SA(0, 0), a2, voffA);
            PG8_WAIT_V(8); PG8_WAIT_L(0); PG8_BAR; PG8_MMA(1, 0, At, B0); PG8_MMA(1, 1, At, B1); PG8_BAR; PG8_SCHED;
            PG8_LDB(B0, 1, 0); PG8_LDB(B1, 1, 1); PG8_SCHED; PG8_LDA(At, 1, 0); PG8_STAGE(PG8_SA(0, 1), a2 + hstepA, voffA);
            PG8_WAIT_V(8); PG8_WAIT_L(0); PG8_BAR; PG8_MMA(0, 0, At, B0); PG8_MMA(0, 1, At, B1); PG8_BAR; PG8_SCHED;
            PG8_LDA(At, 1, 1); PG8_STAGE(PG8_SB(1, 0), b3, voffB); PG8_STAGE(PG8_SB(1, 1), b3 + hstepB, voffB); PG8_STAGE(PG8_SA(1, 0), a3, voffA);
            PG8_WAIT_V(8); PG8_WAIT_L(0); PG8_BAR; PG8_MMA(1, 0, At, B0); PG8_MMA(1, 1, At, B1); PG8_BAR; PG8_SCHED;
            } else {
            PG8_LDB(B0, 0, 0); PG8_SCHED; PG8_LDA(At, 0, 0); PG8_STAGE(PG8_SA(1, 1), a1 + hstepA, voffA);
            PG8_WAIT_L(8); PG8_BAR; PG8_WAIT_L(0); PG8_MMA(0, 0, At, B0); PG8_BAR; PG8_SCHED;
            PG8_LDB(B1, 0, 1); PG8_STAGE(PG8_SB(0, 0), b2, voffB);
            PG8_BAR; PG8_WAIT_L(0); PG8_MMA(0, 1, At, B1); PG8_BAR;
            PG8_LDA(At, 0, 1); PG8_STAGE(PG8_SA(0, 0), a2, voffA);
            PG8_BAR; PG8_WAIT_L(0); PG8_MMA(1, 0, At, B0); PG8_BAR; PG8_SCHED;
            PG8_STAGE(PG8_SB(0, 1), b2 + hstepB, voffB);
            PG8_WAIT_V(6); PG8_BAR; PG8_MMA(1, 1, At, B1); PG8_BAR;
            PG8_LDB(B0, 1, 0); PG8_SCHED; PG8_LDA(At, 1, 0); PG8_STAGE(PG8_SA(0, 1), a2 + hstepA, voffA);
            PG8_WAIT_L(8); PG8_BAR; PG8_WAIT_L(0); PG8_MMA(0, 0, At, B0); PG8_BAR; PG8_SCHED;
            PG8_LDB(B1, 1, 1); PG8_STAGE(PG8_SB(1, 0), b3, voffB);
            PG8_BAR; PG8_WAIT_L(0); PG8_MMA(0, 1, At, B1); PG8_BAR;
            PG8_LDA(At, 1, 1); PG8_STAGE(PG8_SA(1, 0), a3, voffA);
            PG8_BAR; PG8_WAIT_L(0); PG8_MMA(1, 0, At, B0); PG8_BAR; PG8_SCHED;
            PG8_STAGE(PG8_SB(1, 1), b3 + hstepB, voffB);
            PG8_WAIT_V(6); PG8_BAR; PG8_MMA(1, 1, At, B1); PG8_BAR;
            }
        }
        if constexpr (ALIGN_EPI) { if (wr == 0) PG8_BAR; }
        if constexpr (F8) asm volatile("s_nop 15\n\ts_nop 15" ::: "memory");
        E(acc, cur, wr, wc, fr, fq);
        if (!has_next) break;
#pragma unroll
        for (int a = 0; a < 2; ++a)
#pragma unroll
            for (int b = 0; b < 2; ++b)
#pragma unroll
                for (int m = 0; m < 4; ++m)
#pragma unroll
                    for (int n = 0; n < 2; ++n) acc[a][b][m][n] = (f32x4){0.f, 0.f, 0.f, 0.f};
        cur = nxt; cA = nA; cB = nB; ++ui; nt = (cur.nk ? cur.nk : K) * ES / (BK * 2);
        if constexpr (ALIGN_EPI) { if (wr == 1) PG8_BAR; }
    }
    PG8_WAIT_V(0);
    if constexpr (!ALIGN_EPI) { if (wr == 0) PG8_BAR; }
    PG8_BAR;
#undef PG8_UA
#undef PG8_UB
#undef PG8_SA
#undef PG8_SB
#undef PG8_STAGE
#undef PG8_LDA
#undef PG8_LDB
#undef PG8_MMA
#undef PG8_WAIT_V
#undef PG8_WAIT_L
#undef PG8_BAR
#undef PG8_SCHED
}
}

constexpr int NWAVES = 8;
constexpr int N_LAUNCHES = MK_N_LAUNCHES;
constexpr int PER_PHASE = 10;
constexpr int D = 2048, NCTX = 16 * 256, NLAT = 8 * 2048, NTOK = NCTX + NLAT;
constexpr int MW = 1024, NH = 8, DH = 128, PW = 1024, FF = 8192;
constexpr int PROJ_LD = 5120;
constexpr int WIN_ROWS = 5376;
constexpr float EPS = 1e-6f;
constexpr int NMOD = 9;

constexpr size_t MiB = 1u << 20;
constexpr size_t WS_CTL = 0, CTL_ZERO_BYTES = 1 * MiB;
constexpr size_t WS_MOD = 1 * MiB;
constexpr size_t WS_GATES = 2 * MiB;
constexpr int TAIL_PM0 = 64, TAIL_NM = 16;
constexpr size_t WS_POOLWT = 11 * MiB;
constexpr size_t WS_WU = 5 * MiB;
constexpr size_t WS_WIN = 12 * MiB;
constexpr size_t WS_WOUT = 33 * MiB;
constexpr size_t WS_W1 = 41 * MiB;
constexpr size_t WS_W2 = 73 * MiB;
constexpr size_t WS_RB = 108 * MiB;
constexpr size_t WS_PROJ = 188 * MiB;
constexpr size_t WS_HDIR = 388 * MiB;
constexpr size_t WS_PP = 468 * MiB;
constexpr size_t WS_HFF = 188 * MiB;
constexpr size_t WS_END = 508 * MiB;
constexpr int CW_TMO = 0, CW_CODE = 1;
constexpr int CW_BAR = 4096;

constexpr int RING_OFF = 0;
constexpr int KLD = 144, VLD = 80;
constexpr int ML_KB = 0, ML_KB_SZ = 36864;
constexpr int ML_VB = 73728, ML_VB_SZ = 20480;
constexpr int ML_CT = 114688, ML_CT_SZ = 18944;
constexpr int ML_G = 154112, ML_G_SZ = 2048;
constexpr int ML_SC = 158208;
constexpr int LDSCTL_OFF = 158720, MISC_OFF = LDSCTL_OFF + 320;
constexpr int LDS_BYTES = 159744;

#define GAS __attribute__((address_space(1)))
#define LAS __attribute__((address_space(3)))
typedef unsigned short bf16;
typedef unsigned v4u __attribute__((ext_vector_type(4)));
typedef unsigned v2u __attribute__((ext_vector_type(2)));
typedef float f32x4 __attribute__((ext_vector_type(4)));
typedef short bf16x8 __attribute__((ext_vector_type(8)));
typedef GAS unsigned gu32;
#define RLX_AGENT __ATOMIC_RELAXED, __HIP_MEMORY_SCOPE_AGENT
#define LDS_WAIT() asm volatile("s_waitcnt lgkmcnt(0)" ::: "memory")
#define VM_WAIT() asm volatile("s_waitcnt vmcnt(0)" ::: "memory")
typedef __bf16 bf16x2_t __attribute__((ext_vector_type(2)));
__device__ __forceinline__ unsigned pk2(float lo, float hi) { const bf16x2_t v = {(__bf16)lo, (__bf16)hi}; return __builtin_bit_cast(unsigned, v); }
__device__ __forceinline__ float bflo(unsigned w) { return __uint_as_float(w << 16); }
__device__ __forceinline__ float bfhi(unsigned w) { return __uint_as_float(w & 0xffff0000u); }
__device__ __forceinline__ float bf2f(bf16 b) { return __uint_as_float((unsigned)b << 16); }

#define XB_TMO      128
#define XB_XCNT(j)  (256  + 64 * (j))
#define XB_XSUB(j)  (1280 + 64 * (j))
#define XB_XGEN(j)  (2304 + 64 * (j))
#define XB_TOP      3328
#define XB_TOPGEN   3392
#define XCD_BAR_WORDS 3456
#define XB_SPIN_CAP (1u << 18)
__device__ __forceinline__ unsigned xb_ld(unsigned* p)              { return __hip_atomic_load(p, __ATOMIC_RELAXED, __HIP_MEMORY_SCOPE_AGENT); }
__device__ __forceinline__ unsigned xb_add(unsigned* p, unsigned v) { return __hip_atomic_fetch_add(p, v, __ATOMIC_RELAXED, __HIP_MEMORY_SCOPE_AGENT); }
__device__ __forceinline__ unsigned xb_xcc_id() { return (unsigned)__builtin_amdgcn_s_getreg((3 << 11) | 20) & 0xFu; }
#define XB_SPIN(cond, bar) do { unsigned _sp = 0; while (cond) { __builtin_amdgcn_s_sleep(1); \
    if ((++_sp & 255u) == 0u) { if (xb_ld(&(bar)[XB_TMO])) break; if (_sp > XB_SPIN_CAP) { atomicAdd(&(bar)[XB_TMO], 1u); break; } } } } while (0)
struct XcdBarrier { unsigned* bar; unsigned x; volatile LAS unsigned* st; };
__device__ __forceinline__ XcdBarrier xcd_barrier_post(unsigned* bar, volatile LAS unsigned* st) {
    XcdBarrier b; b.bar = bar; b.x = xb_xcc_id(); b.st = st;
    if (threadIdx.x == 0) (void)xb_add(&bar[XB_XCNT(b.x)], 1u);
    return b;
}
__device__ __forceinline__ void xcd_barrier_complete(unsigned* bar, unsigned x, unsigned& nloc, unsigned& nx) {
    const unsigned G = gridDim.x * gridDim.y * gridDim.z;
    unsigned sum, cnt, mine, sp = 0u;
    for (;;) {
        sum = 0u; cnt = 0u; mine = 0u;
#pragma unroll
        for (unsigned j = 0; j < 16; ++j) { const unsigned c = xb_ld(&bar[XB_XCNT(j)]); sum += c; cnt += (c > 0u) ? 1u : 0u; mine = (j == x) ? c : mine; }
        if (sum == G) break;
        __builtin_amdgcn_s_sleep(1);
        if ((++sp & 255u) == 0u) { if (xb_ld(&bar[XB_TMO])) break; if (sp > XB_SPIN_CAP) { atomicAdd(&bar[XB_TMO], 1u); break; } }
    }
    nloc = mine > 0u ? mine : 1u; nx = cnt > 0u ? cnt : 1u;
}
__device__ __forceinline__ void xcd_barrier(const XcdBarrier& b) {
    asm volatile("s_waitcnt vmcnt(0)" ::: "memory");
    __syncthreads();
    if (threadIdx.x == 0) {
        unsigned* bar = b.bar;
        __builtin_amdgcn_s_waitcnt(0);
        unsigned nloc = b.st[0], nx = b.st[1];
        if (nloc == 0u) { xcd_barrier_complete(bar, b.x, nloc, nx); b.st[0] = nloc; b.st[1] = nx; }
        const unsigned old = xb_add(&bar[XB_XSUB(b.x)], 1u);
        const unsigned gen = old / nloc;
        if (old + 1u == (gen + 1u) * nloc) {
            __builtin_amdgcn_fence(__ATOMIC_RELEASE, "agent");
            asm volatile("s_waitcnt vmcnt(0)" ::: "memory");
            const unsigned og = xb_add(&bar[XB_TOP], 1u);
            const unsigned tg = og / nx;
            if (og + 1u == (tg + 1u) * nx) xb_add(&bar[XB_TOPGEN], 1u);
            else XB_SPIN(xb_ld(&bar[XB_TOPGEN]) == tg, bar);
            __builtin_amdgcn_fence(__ATOMIC_ACQUIRE, "agent");
            xb_add(&bar[XB_XGEN(b.x)], 1u);
            asm volatile("s_waitcnt vmcnt(0)" ::: "memory");
        } else {
            XB_SPIN(xb_ld(&bar[XB_XGEN(b.x)]) == gen, bar);
            __builtin_amdgcn_fence(__ATOMIC_ACQUIRE, "agent");
            asm volatile("s_waitcnt vmcnt(0)" ::: "memory");
        }
    }
    __syncthreads();
}

struct Args { const float* in[18]; float* out; unsigned char* ws; int ph_lo, ph_hi, li, pad; };
struct Frame {
    LAS unsigned char* lds;
    volatile LAS unsigned* MISC;
    int tid, lane, wave;
    int vcu, G;
    const Args* a;
};
#define F_xp (F.a->in[0])
#define F_xs (F.a->in[1])
#define F_cc (F.a->in[2])
#define F_stC (F.a->in[3])
#define F_stN (F.a->in[4])
#define F_stM (F.a->in[5])
#define F_cctx (F.a->in[6])
#define F_w_in (F.a->in[7])
#define F_gate_bias (F.a->in[8])
#define F_mnw (F.a->in[9])
#define F_pool_w (F.a->in[10])
#define F_pool_scale (F.a->in[11])
#define F_w_out (F.a->in[12])
#define F_ada_w (F.a->in[13])
#define F_ada_b (F.a->in[14])
#define F_norm_w (F.a->in[15])
#define F_w1 (F.a->in[16])
#define F_w2 (F.a->in[17])
#define F_out (F.a->out)
#define F_ctl ((gu32*)(F.a->ws + WS_CTL))
#define F_MOD ((float*)(F.a->ws + WS_MOD))
#define F_GATES ((float*)(F.a->ws + WS_GATES))
#define F_MIX1 ((bf16*)(F.a->ws + WS_PP))
#define F_Y1 ((bf16*)(F.a->ws + WS_WIN))
#define F_PoolWT ((bf16*)(F.a->ws + WS_POOLWT))
#define F_WU ((bf16*)(F.a->ws + WS_WU))
#define F_WinT ((bf16*)(F.a->ws + WS_WIN))
#define F_WoutT ((bf16*)(F.a->ws + WS_WOUT))
#define F_W1T ((bf16*)(F.a->ws + WS_W1))
#define F_W2T ((bf16*)(F.a->ws + WS_W2))
#define F_RB ((bf16*)(F.a->ws + WS_RB))
#define F_PROJ ((bf16*)(F.a->ws + WS_PROJ))
#define F_HDIR ((bf16*)(F.a->ws + WS_HDIR))
#define F_HFF ((bf16*)(F.a->ws + WS_HFF))

__device__ __forceinline__ int fresh_lane() { int l; asm volatile("v_mbcnt_lo_u32_b32 %0, -1, 0\n\tv_mbcnt_hi_u32_b32 %0, -1, %0" : "=v"(l)); return l; }
__device__ __forceinline__ float wave_sum(float v) {
#pragma unroll
    for (int o = 1; o < 64; o <<= 1) v += __shfl_xor(v, o);
    return v;
}
__device__ __forceinline__ const float* xrow_ptr(const Frame& F, int m) { return m < NCTX ? F_xp + (size_t)m * D : F_xs + (size_t)(m - NCTX) * D; }
__device__ __forceinline__ int modrow(int m) { return m < NCTX ? 0 : 1 + ((m - NCTX) >> 11); }

constexpr float W1_SCALE = 32.f, H2_SCALE = 8.f;
__device__ __forceinline__ void p0_transpose_item(const float* W, int N, bf16* WT, int ldk, int k0, int n0, int drow0, LAS float* scr, int lane, const float* nscale = nullptr, float cscale = 1.f) {
    { const int kr = lane >> 3, nq = lane & 7; f32x4 v[8];
#pragma unroll
        for (int i = 0; i < 8; ++i) v[i] = __builtin_nontemporal_load((const GAS f32x4*)(W + (size_t)(k0 + 8 * i + kr) * N + n0 + 4 * nq));
#pragma unroll
        for (int i = 0; i < 8; ++i) { LAS float* d = scr + (8 * i + kr) * 33 + 4 * nq; d[0] = v[i].x; d[1] = v[i].y; d[2] = v[i].z; d[3] = v[i].w; } }
    LDS_WAIT(); asm volatile("" ::: "memory");
    const int c = lane & 7;
#pragma unroll
    for (int j = 0; j < 4; ++j) { const int n = (lane >> 3) + 8 * j; const LAS float* s = scr + (8 * c) * 33 + n;
        const float sc = (nscale ? nscale[n] : 1.f) * cscale;
        v4u o; o.x = pk2(s[0 * 33] * sc, s[1 * 33] * sc); o.y = pk2(s[2 * 33] * sc, s[3 * 33] * sc); o.z = pk2(s[4 * 33] * sc, s[5 * 33] * sc); o.w = pk2(s[6 * 33] * sc, s[7 * 33] * sc);
        *(GAS v4u*)(WT + (size_t)(drow0 + n) * ldk + k0 + 8 * c) = o; }
    LDS_WAIT(); asm volatile("" ::: "memory");
}
__device__ __forceinline__ void p0_transpose_item_f8(const float* W, int N, unsigned char* WT, int ldk, int k0, int n0, LAS float* scr, int lane, float sc) {
    { const int kr = lane >> 3, nq = lane & 7; f32x4 v[8];
#pragma unroll
        for (int i = 0; i < 8; ++i) v[i] = __builtin_nontemporal_load((const GAS f32x4*)(W + (size_t)(k0 + 8 * i + kr) * N + n0 + 4 * nq));
#pragma unroll
        for (int i = 0; i < 8; ++i) { LAS float* d = scr + (8 * i + kr) * 33 + 4 * nq; d[0] = v[i].x; d[1] = v[i].y; d[2] = v[i].z; d[3] = v[i].w; } }
    LDS_WAIT(); asm volatile("" ::: "memory");
    const int c = lane & 7;
#pragma unroll
    for (int j = 0; j < 4; ++j) { const int n = (lane >> 3) + 8 * j; const LAS float* s = scr + (8 * c) * 33 + n;
        int w0 = __builtin_amdgcn_cvt_pk_fp8_f32(s[0 * 33] * sc, s[1 * 33] * sc, 0, false); w0 = __builtin_amdgcn_cvt_pk_fp8_f32(s[2 * 33] * sc, s[3 * 33] * sc, w0, true);
        int w1 = __builtin_amdgcn_cvt_pk_fp8_f32(s[4 * 33] * sc, s[5 * 33] * sc, 0, false); w1 = __builtin_amdgcn_cvt_pk_fp8_f32(s[6 * 33] * sc, s[7 * 33] * sc, w1, true);
        *(GAS v2u*)(WT + (size_t)(n0 + n) * ldk + k0 + 8 * c) = (v2u){(unsigned)w0, (unsigned)w1}; }
    LDS_WAIT(); asm volatile("" ::: "memory");
}
__device__ __forceinline__ void p0_transposes(Frame& F, int part, int wg, int nwg) {
    LAS float* scr = (LAS float*)(F.lds + RING_OFF + F.wave * 16384);
    const int gw = wg * NWAVES + F.wave, NGW = nwg * NWAVES;
    constexpr int I_IN = (D / 64) * (5152 / 32), I_OUT = (D / 64) * (D / 32), I_1 = (D / 64) * (FF / 32), I_2 = (FF / 64) * (D / 32), I_P = 4 * (256 / 64) * (256 / 32);
    if (part == 0) {
        constexpr int NB = 4128 / 32, I_INQ = (D / 64) * NB, I_WU = D;
        for (int it = gw; it < I_INQ + I_P + I_WU; it += NGW) { int r = it;
            if (r < I_INQ) { const int kb = r / NB, nb = r % NB, n0 = 32 * nb; const int dr = n0 < 4096 ? n0 : 5120;
                p0_transpose_item(F_w_in, 5152, F_WinT, D, 64 * kb, n0, dr, scr, F.lane, nullptr, n0 < 1024 ? 0.08838834764831845f : 1.f); continue; } r -= I_INQ;
            if (r < I_P) { const int g = r / 32, q = r % 32, kb = q / 8, nb = q % 8; p0_transpose_item(F_pool_w + (size_t)g * 65536, 256, F_PoolWT, 256, 64 * kb, 32 * nb, g * 256 + 32 * nb, scr, F.lane, F_pool_scale + g * 256 + 32 * nb); continue; } r -= I_P;
            { const GAS f32x4* s = (const GAS f32x4*)(F_w_in + (size_t)r * 5152 + 4128) + 4 * F.lane; const f32x4 a = s[0], b = s[1], c = s[2], d = s[3];
              GAS v4u* o = (GAS v4u*)(F_WU + (size_t)r * 1024) + 2 * F.lane; o[0] = (v4u){pk2(a.x, a.y), pk2(a.z, a.w), pk2(b.x, b.y), pk2(b.z, b.w)}; o[1] = (v4u){pk2(c.x, c.y), pk2(c.z, c.w), pk2(d.x, d.y), pk2(d.z, d.w)}; } }
        return;
    }
    constexpr int NITEMS = I_OUT + I_1 + I_2;
    for (int it = gw; it < NITEMS; it += NGW) {
        int r = it;
        if (r < I_OUT) { const int nblk = D / 32, kb = r / nblk, nb = r % nblk; p0_transpose_item_f8(F_w_out, D, (unsigned char*)F_WoutT, D, 64 * kb, 32 * nb, scr, F.lane, 64.f); continue; } r -= I_OUT;
        if (r < I_1) { const int nblk = FF / 32, kb = r / nblk, nb = r % nblk; p0_transpose_item_f8(F_w1, FF, (unsigned char*)F_W1T, D, 64 * kb, 32 * nb, scr, F.lane, W1_SCALE); continue; } r -= I_1;
        { const int nblk = D / 32, kb = r / nblk, nb = r % nblk; p0_transpose_item_f8(F_w2, D, (unsigned char*)F_W2T, FF, 64 * kb, 32 * nb, scr, F.lane, 64.f); }
    }
}
__device__ __forceinline__ void p0_mod_gemv(Frame& F) {
    LAS float* sil = (LAS float*)(F.lds);
    LAS float* red = (LAS float*)(F.lds + 73728);
    bool have = false;
    for (int item = F.vcu; item < 192; item += F.G) {
        if (!have) {
            { float cv[4][NMOD];
#pragma unroll
                for (int j = 0; j < 4; ++j) { const int k = F.tid + 512 * j; cv[j][0] = F_cctx[k];
#pragma unroll
                    for (int r = 1; r < NMOD; ++r) cv[j][r] = F_cc[(size_t)(r - 1) * D + k]; }
#pragma unroll
                for (int j = 0; j < 4; ++j) { const int k = F.tid + 512 * j;
#pragma unroll
                    for (int r = 0; r < NMOD; ++r) { const float c = cv[j][r]; sil[k * NMOD + r] = c / (1.f + __expf(-c)); } } }
            have = true;
        }
        __syncthreads();
        const int n0 = item * 64, kq = F.tid >> 4, c4 = F.tid & 15;
        float acc[NMOD][4];
#pragma unroll
        for (int r = 0; r < NMOD; ++r) { acc[r][0] = 0.f; acc[r][1] = 0.f; acc[r][2] = 0.f; acc[r][3] = 0.f; }
        const GAS f32x4* wp = (const GAS f32x4*)(F_ada_w + n0) + c4;
        for (int ib = 0; ib < 64; ib += 16) {
            f32x4 wv[16];
#pragma unroll
            for (int j = 0; j < 16; ++j) wv[j] = wp[(size_t)(kq + 32 * (ib + j)) * (12288 / 4)];
#pragma unroll
            for (int j = 0; j < 16; ++j) { const int k = kq + 32 * (ib + j); const f32x4 w = wv[j];
                if ((j & 3) == 0) __builtin_amdgcn_sched_barrier(0);
#pragma unroll
                for (int r = 0; r < NMOD; ++r) { const float s = sil[k * NMOD + r]; acc[r][0] += s * w.x; acc[r][1] += s * w.y; acc[r][2] += s * w.z; acc[r][3] += s * w.w; } } }
#pragma unroll
        for (int r = 0; r < NMOD; ++r)
#pragma unroll
            for (int j = 0; j < 4; ++j) { float v = acc[r][j]; v += __shfl_xor(v, 16); v += __shfl_xor(v, 32); acc[r][j] = v; }
        if (F.lane < 16) {
#pragma unroll
            for (int r = 0; r < NMOD; ++r)
#pragma unroll
                for (int j = 0; j < 4; ++j) red[(F.wave * NMOD + r) * 64 + 4 * c4 + j] = acc[r][j];
        }
        __syncthreads();
        for (int o = F.tid; o < NMOD * 64; o += NWAVES * 64) { const int r = o / 64, c = o % 64; float s = F_ada_b[n0 + c];
#pragma unroll
            for (int w = 0; w < 8; ++w) s += red[(w * NMOD + r) * 64 + c];
            F_MOD[(size_t)r * 12288 + n0 + c] = s; }
    }
    __syncthreads();
}
struct RowSeg { int lo, hi, mr; };
__device__ __forceinline__ bool next_seg(int& cur, int r_hi, RowSeg& s) {
    if (cur >= r_hi) return false;
    s.lo = cur; s.mr = modrow(cur); const int bound = s.mr == 0 ? NCTX : NCTX + s.mr * 2048; s.hi = bound < r_hi ? bound : r_hi; cur = s.hi; return true;
}
__device__ __forceinline__ void p1_h1(Frame& F) {
    const int lane = fresh_lane();
    const int bx = blockIdx.x; int r_lo, r_hi;
    if (F.G == 256) { r_lo = bx < 32 ? 66 * bx : 2112 + 82 * (bx - 32); r_hi = r_lo + (bx < 32 ? 66 : 82); } else { const int rp = (NTOK + F.G - 1) / F.G; r_lo = min(NTOK, bx * rp); r_hi = min(NTOK, r_lo + rp); }
    for (int u = bx; u < 32; u += F.G) {
        pg8::Gemm gm{F_PoolWT, F_WU, 256, 256, 1024, 0x7F7F7F7Fu};
        pg8::OneUnit S{{u >> 3, u & 7, 0, 256 * (u >> 3), 0}};
        pg8::EpiBf16<0, false> E{F_WinT + (size_t)4096 * D, D, nullptr, 0, 1.f};
        pg8::gemm_phase<pg8::EpiBf16<0, false>, pg8::OneUnit, false, true>(F.lds + RING_OFF, gm, S, E);
    }
    LAS f32x4* pA = (LAS f32x4*)(F.lds); LAS f32x4* pC = pA + D / 4;
    int cur = r_lo; RowSeg sg;
    while (next_seg(cur, r_hi, sg)) {
        const float* mod = F_MOD + (size_t)sg.mr * 12288;
        for (int i = F.tid; i < D / 4; i += NWAVES * 64) { const f32x4 w = *(const f32x4*)(F_norm_w + 4 * i), sc = *(const f32x4*)(mod + 2048 + 4 * i); pA[i] = w * (sc + 1.f); pC[i] = *(const f32x4*)(mod + 4 * i); }
        __syncthreads();
        for (int m = sg.lo + F.wave; m < sg.hi; m += NWAVES) {
            const GAS f32x4* xr = (const GAS f32x4*)xrow_ptr(F, m) + lane;
            f32x4 v[8]; float s = 0.f;
#pragma unroll
            for (int j = 0; j < 8; ++j) { v[j] = xr[64 * j]; s += (v[j].x * v[j].x + v[j].y * v[j].y) + (v[j].z * v[j].z + v[j].w * v[j].w); }
            const float rstd = rsqrtf(wave_sum(s) * (1.f / D) + EPS);
            GAS v2u* o8 = (GAS v2u*)(F_RB + (size_t)m * D) + lane;
#pragma unroll
            for (int j = 0; j < 8; ++j) { const f32x4 h = v[j] * rstd * pA[lane + 64 * j] + pC[lane + 64 * j];
                v2u o; o.x = pk2(h.x, h.y); o.y = pk2(h.z, h.w); o8[64 * j] = o; }
        }
        __syncthreads();
    }
}
typedef short s16x4 __attribute__((ext_vector_type(4)));
__device__ __forceinline__ bf16x8 tr_pair(const LAS bf16* p, int ld) {
    const s16x4 a = __builtin_amdgcn_ds_read_tr16_b64_v4i16((LAS s16x4*)p);
    const s16x4 b = __builtin_amdgcn_ds_read_tr16_b64_v4i16((LAS s16x4*)(p + 16 * ld));
    return (bf16x8){a[0], a[1], a[2], a[3], b[0], b[1], b[2], b[3]};
}
struct GatePre { float gi0, gi1, gf0, gf1; };
__device__ __forceinline__ GatePre gate_load(const float* GATES, int seqbase, int T, int dir, int c, int lane, int gi_col, int gf_col) {
    typedef float f32x2_t __attribute__((ext_vector_type(2)));
    const int j0 = c * 128 + 2 * lane, lo = dir ? T - 2 - j0 : j0;
    const f32x2_t vi = *(const GAS f32x2_t*)(GATES + (size_t)gi_col * NTOK + seqbase + lo), vf = *(const GAS f32x2_t*)(GATES + (size_t)gf_col * NTOK + seqbase + lo);
    GatePre g; g.gi0 = dir ? vi.y : vi.x; g.gi1 = dir ? vi.x : vi.y; g.gf0 = dir ? vf.y : vf.x; g.gf1 = dir ? vf.x : vf.y; return g;
}
__device__ __forceinline__ float logsig(float x) { return fminf(x, 0.f) - log1pf(__expf(-fabsf(x))); }
__device__ __forceinline__ float gate_finish(const GatePre g, float bias_i, float bias_f, float mchunk, LAS float* gb, LAS float* sc, int lane) {
    const float li0 = g.gi0 + bias_i, li1 = g.gi1 + bias_i, lf0 = logsig(g.gf0 + bias_f), lf1 = logsig(g.gf1 + bias_f);
    const float c1 = lf0 + lf1; float incl = c1;
#pragma unroll
    for (int o = 1; o < 64; o <<= 1) { const float v = __shfl_up(incl, o); if (lane >= o) incl += v; }
    const float excl = incl - c1, b0 = excl + lf0, b1 = incl;
    const float a0 = li0 - b0, a1 = li1 - b1, p1 = fmaxf(a0, a1); float im = p1;
#pragma unroll
    for (int o = 1; o < 64; o <<= 1) { const float v = __shfl_up(im, o); if (lane >= o) im = fmaxf(im, v); }
    float em = __shfl_up(im, 1); if (lane == 0) em = -INFINITY;
    const float M0 = fmaxf(mchunk, fmaxf(em, a0)), M1 = fmaxf(mchunk, im);
    const float Mlast = __shfl(M1, 63), blast = __shfl(b1, 63);
    typedef float f32x2 __attribute__((ext_vector_type(2)));
    *(LAS f32x2*)(gb + 2 * lane) = (f32x2){a0 * 1.44269504089f, a1 * 1.44269504089f};
    *(LAS f32x2*)(gb + 128 + 2 * lane) = (f32x2){M0, M1};
    *(LAS f32x2*)(gb + 256 + 2 * lane) = (f32x2){b0 + M0, b1 + M1};
    *(LAS f32x2*)(gb + 384 + 2 * lane) = (f32x2){__expf(a0 - Mlast), __expf(a1 - Mlast)};
    const float mnext = blast + Mlast;
    if (lane == 0) { sc[0] = mchunk; sc[1] = mnext; }
    return mnext;
}
#define ML_EP(i, j) (32 * ((i) >> 1) + 8 * ((j) >> 2) + 4 * ((i) & 1) + ((j) & 3))
template <int TT> __device__ __forceinline__ void mlstm_unit(Frame& F, int path, int b, int h, int dir, int eh) {
    const int T = path ? 2048 : 256, nc = T / 128, seqbase = path ? NCTX + b * 2048 : b * 256;
    constexpr int w = TT < 4 ? TT : 11 - TT, tt = TT;
    const int lane = fresh_lane(), tid = w * 64 + lane, lr = lane & 15, lq = lane >> 4, q4 = lr >> 2, p4 = lr & 3;
    const int sidx = ((b * 2 + dir) * NH + h);
    const float* GATES = F_GATES; const bf16* PROJ = F_PROJ;
    f32x4 accC[5];
#pragma unroll
    for (int i = 0; i < 5; ++i) accC[i] = (f32x4){0.f, 0.f, 0.f, 0.f};
    float m0 = 0.f;
    if (path) {
        const float* C0 = F_stC + (size_t)sidx * DH * DH;
#pragma unroll
        for (int i = 0; i < 4; ++i)
#pragma unroll
            for (int r = 0; r < 4; ++r) accC[i][r] = C0[(size_t)(16 * w + 4 * lq + r) * DH + 64 * eh + ML_EP(i, lr)];
        if (lr == 0) {
#pragma unroll
            for (int r = 0; r < 4; ++r) accC[4][r] = F_stN[(size_t)sidx * DH + 16 * w + 4 * lq + r]; }
        m0 = F_stM[sidx];
    }
    const int gi_col = (dir ? 16 : 0) + h, gf_col = (dir ? 24 : 8) + h;
    const float bias_i = F_gate_bias[gi_col], bias_f = F_gate_bias[gf_col];
    float mchain = m0;
    if (w == 0) { const GatePre g = gate_load(GATES, seqbase, T, dir, 0, lane, gi_col, gf_col);
        mchain = gate_finish(g, bias_i, bias_f, mchain, (LAS float*)(F.lds + ML_G), (LAS float*)(F.lds + ML_SC), lane); }
    { LAS bf16* CT = (LAS bf16*)(F.lds + ML_CT);
#pragma unroll
        for (int i = 0; i < 5; ++i) if (i < 4 || lr == 0) { v2u o; o.x = pk2(accC[i][0], accC[i][1]); o.y = pk2(accC[i][2], accC[i][3]); *(LAS v2u*)(CT + (16 * i + lr) * KLD + 16 * w + 4 * lq) = o; } }
    constexpr bool LDR = (w < 4); constexpr int NKL = LDR ? 8 : 0, NVL = LDR ? 4 : 0;
    const int krow = (tid & 255) >> 4, kch = tid & 15, vrow = (tid & 255) >> 3, vch = tid & 7;
    v4u kv[8], vv[4]; bf16x8 bq[4], bqn[4]; v4u hold[2];
#pragma unroll
    for (int i = 0; i < 4; ++i) { bqn[i] = (bf16x8){0, 0, 0, 0, 0, 0, 0, 0}; hold[i >> 1] = (v4u){0u, 0u, 0u, 0u}; }
    {
#pragma unroll
        for (int i = 0; i < NKL; ++i) { const int s = krow + 16 * i, stok = dir ? T - 1 - s : s; kv[i] = *(const GAS v4u*)(PROJ + (size_t)(seqbase + stok) * PROJ_LD + 1024 + h * DH + kch * 8); }
#pragma unroll
        for (int i = 0; i < NVL; ++i) { const int s = vrow + 32 * i, stok = dir ? T - 1 - s : s; vv[i] = *(const GAS v4u*)(PROJ + (size_t)(seqbase + stok) * PROJ_LD + 2048 + h * DH + 64 * eh + vch * 8); }
        const int qtok = dir ? T - 1 - (16 * tt + lr) : 16 * tt + lr; const bf16* qrow = PROJ + (size_t)(seqbase + qtok) * PROJ_LD + h * DH + 8 * lq;
#pragma unroll
        for (int kk = 0; kk < 4; ++kk) bq[kk] = *(const GAS bf16x8*)(qrow + 32 * kk); }
    if constexpr (LDR) asm volatile("" :: "v"(kv[0]), "v"(kv[1]), "v"(kv[2]), "v"(kv[3]), "v"(kv[4]), "v"(kv[5]), "v"(kv[6]), "v"(kv[7]), "v"(vv[0]), "v"(vv[1]), "v"(vv[2]), "v"(vv[3]));
    asm volatile("" :: "v"(bq[0]), "v"(bq[1]), "v"(bq[2]), "v"(bq[3]));
    const bf16x8 ones = (lr == 0) ? (bf16x8){0x3F80, 0x3F80, 0x3F80, 0x3F80, 0x3F80, 0x3F80, 0x3F80, 0x3F80} : (bf16x8){0, 0, 0, 0, 0, 0, 0, 0};
    for (int c = 0; c < nc; ++c) {
        const int buf = c & 1;
        LAS bf16* Kb = (LAS bf16*)(F.lds + ML_KB + buf * ML_KB_SZ); LAS bf16* Vb = (LAS bf16*)(F.lds + ML_VB + buf * ML_VB_SZ);
        const LAS bf16* CTb = (const LAS bf16*)(F.lds + ML_CT + buf * ML_CT_SZ);
        const LAS float* gb = (const LAS float*)(F.lds + ML_G + buf * ML_G_SZ); const LAS float* sc = (const LAS float*)(F.lds + ML_SC + buf * 16);
#pragma unroll
        for (int i = 0; i < NKL; ++i) *(LAS v4u*)(Kb + (krow + 16 * i) * KLD + kch * 8) = kv[i];
#pragma unroll
        for (int i = 0; i < NVL; ++i) { LAS bf16* vd = Vb + (vrow + 32 * i) * VLD + 32 * (vch >> 2) + 4 * (vch & 3);
            *(LAS v2u*)vd = (v2u){vv[i].x, vv[i].y}; *(LAS v2u*)(vd + 16) = (v2u){vv[i].z, vv[i].w}; }
        __syncthreads();
        const bool more = (c + 1 < nc);
        const int t = 16 * tt + lr;
        const int cn = more ? c + 1 : c, cp = c > 0 ? c - 1 : 0;
        GatePre gpre; gpre.gi0 = 0.f; gpre.gi1 = 0.f; gpre.gf0 = 0.f; gpre.gf1 = 0.f;
        if (w == 0) gpre = gate_load(GATES, seqbase, T, dir, cn, lane, gi_col, gf_col);
#define ML_VM_ST do { const int tok = dir ? T - 1 - (cp * 128 + t) : cp * 128 + t; bf16* hp = F_HDIR + ((size_t)dir * NTOK + seqbase + tok) * MW + h * DH + 64 * eh + 8 * lq; \
            *(GAS v4u*)hp = hold[0]; *(GAS v4u*)(hp + 32) = hold[1]; } while (0)
#define ML_VM_K(i0) do { if constexpr (LDR) { _Pragma("unroll") for (int i = (i0); i < (i0) + 2; ++i) { const int s = cn * 128 + krow + 16 * i, stok = dir ? T - 1 - s : s; \
            kv[i] = *(const GAS v4u*)(PROJ + (size_t)(seqbase + stok) * PROJ_LD + 1024 + h * DH + kch * 8); } } } while (0)
#define ML_VM_V(i0) do { if constexpr (LDR) { _Pragma("unroll") for (int i = (i0); i < (i0) + 2; ++i) { const int s = cn * 128 + vrow + 32 * i, stok = dir ? T - 1 - s : s; \
            vv[i] = *(const GAS v4u*)(PROJ + (size_t)(seqbase + stok) * PROJ_LD + 2048 + h * DH + 64 * eh + vch * 8); } } } while (0)
#define ML_VM_Q(k0) do { const int qtok = dir ? T - 1 - (cn * 128 + t) : cn * 128 + t; const bf16* qrow = PROJ + (size_t)(seqbase + qtok) * PROJ_LD + h * DH + 8 * lq; \
            _Pragma("unroll") for (int kk = (k0); kk < (k0) + 2; ++kk) bqn[kk] = *(const GAS bf16x8*)(qrow + 32 * kk); } while (0)
        const float Mt = gb[128 + t], mt = gb[256 + t], Mlast = gb[128 + 127], mcur = sc[0];
#define ML_SB __builtin_amdgcn_sched_barrier(0)
#define ML_LOADK(dst, kk) do { _Pragma("unroll") for (int si = 0; si < 8; ++si) if (si <= tt) dst[si] = *(const LAS bf16x8*)(Kb + (16 * si + lr) * KLD + 32 * (kk) + 8 * lq); } while (0)
#define ML_MMAK(src, kk) do { _Pragma("unroll") for (int si = 0; si < 8; ++si) if (si <= tt) st[si] = __builtin_amdgcn_mfma_f32_16x16x32_bf16(src[si], bq[kk], st[si], 0, 0, 0); } while (0)
#define ML_LOADC(dst, kk) do { _Pragma("unroll") for (int i = 0; i < 5; ++i) dst[i] = *(const LAS bf16x8*)(CTb + (16 * i + lr) * KLD + 32 * (kk) + 8 * lq); } while (0)
#define ML_MMAC(src, kk) do { _Pragma("unroll") for (int i = 0; i < 5; ++i) nm[i] = __builtin_amdgcn_mfma_f32_16x16x32_bf16(src[i], bq[kk], nm[i], 0, 0, 0); } while (0)
#define ML_LOADV(vf, ak, wa, wb, kk) do { _Pragma("unroll") for (int i = 0; i < 4; ++i) vf[i] = tr_pair(Vb + (32 * (kk) + 4 * lq + q4) * VLD + 16 * i + 4 * p4, VLD); \
            ak = tr_pair(Kb + (32 * (kk) + 4 * lq + q4) * KLD + 16 * w + 4 * p4, KLD); \
            wa = *(const LAS f32x4*)(gb + 384 + 32 * (kk) + 4 * lq); wb = *(const LAS f32x4*)(gb + 384 + 32 * (kk) + 16 + 4 * lq); } while (0)
#define ML_KSTEP(vf, ak, wa, wb, kk) do { \
            if (2 * (kk) <= tt) { \
                _Pragma("unroll") for (int i = 0; i < 4; ++i) nm[i] = __builtin_amdgcn_mfma_f32_16x16x32_bf16(vf[i], bp[kk], nm[i], 0, 0, 0); \
                nm[4] = __builtin_amdgcn_mfma_f32_16x16x32_bf16(ones, bp[kk], nm[4], 0, 0, 0); } \
            const v4u ar = __builtin_bit_cast(v4u, ak); \
            const v4u aw = (v4u){pk2(bflo(ar[0]) * wa[0], bfhi(ar[0]) * wa[1]), pk2(bflo(ar[1]) * wa[2], bfhi(ar[1]) * wa[3]), pk2(bflo(ar[2]) * wb[0], bfhi(ar[2]) * wb[1]), pk2(bflo(ar[3]) * wb[2], bfhi(ar[3]) * wb[3])}; \
            const bf16x8 akw = __builtin_bit_cast(bf16x8, aw); \
            _Pragma("unroll") for (int i = 0; i < 4; ++i) accC[i] = __builtin_amdgcn_mfma_f32_16x16x32_bf16(akw, vf[i], accC[i], 0, 0, 0); \
            accC[4] = __builtin_amdgcn_mfma_f32_16x16x32_bf16(akw, ones, accC[4], 0, 0, 0); } while (0)
        f32x4 st[8], nm[5];
#pragma unroll
        for (int si = 0; si < 8; ++si) st[si] = (f32x4){0.f, 0.f, 0.f, 0.f};
#pragma unroll
        for (int i = 0; i < 5; ++i) nm[i] = (f32x4){0.f, 0.f, 0.f, 0.f};
        bf16x8 va[4], vb[4], aka, akb; f32x4 waa, wba, wab, wbb; f32x4 av[8];
        {
            bf16x8 fa[8], fb[8];
            ML_LOADK(fa, 0); ML_SB; ML_LOADK(fb, 1); ML_SB; ML_MMAK(fa, 0); ML_VM_K(0); ML_SB; ML_LOADK(fa, 2); ML_SB; ML_MMAK(fb, 1); ML_VM_K(2); ML_SB; ML_LOADK(fb, 3); ML_SB; ML_MMAK(fa, 2); ML_VM_K(4); ML_SB;
            ML_LOADC(fa, 0); ML_SB; ML_MMAK(fb, 3); ML_VM_K(6); ML_SB; ML_LOADC(fb, 1); ML_SB; ML_MMAC(fa, 0); ML_VM_V(0); ML_VM_Q(0); ML_SB; ML_LOADC(fa, 2); ML_SB; ML_MMAC(fb, 1); ML_VM_V(2); ML_VM_Q(2); ML_SB; ML_LOADC(fb, 3); ML_SB; ML_MMAC(fa, 2); ML_VM_ST; ML_SB;
            ML_LOADV(va, aka, waa, wba, 0);
#pragma unroll
            for (int si = 0; si < 8; ++si) if (si <= tt) av[si] = *(const LAS f32x4*)(gb + 16 * si + 4 * lq);
            ML_SB; ML_MMAC(fb, 3); ML_SB;
        }
        const float gt = __expf(mcur - Mt), gs = __expf(mcur - Mlast);
#pragma unroll
        for (int i = 0; i < 5; ++i) { nm[i] = nm[i] * gt; accC[i] = accC[i] * gs; }
        const float Mt2 = Mt * 1.44269504089f;
#pragma unroll
        for (int si = 0; si < 8; ++si) if (si <= tt) {
#pragma unroll
            for (int r = 0; r < 4; ++r) { const float p = st[si][r] * __builtin_amdgcn_exp2f(av[si][r] - Mt2); st[si][r] = (si < tt || 4 * lq + r <= lr) ? p : 0.f; } }
        bf16x8 bp[4];
#pragma unroll
        for (int kk = 0; kk < 4; ++kk) { const v4u pw = (v4u){pk2(st[2 * kk][0], st[2 * kk][1]), pk2(st[2 * kk][2], st[2 * kk][3]), pk2(st[2 * kk + 1][0], st[2 * kk + 1][1]), pk2(st[2 * kk + 1][2], st[2 * kk + 1][3])};
            bp[kk] = __builtin_bit_cast(bf16x8, pw); }
        ML_SB; ML_LOADV(vb, akb, wab, wbb, 1); ML_SB; ML_KSTEP(va, aka, waa, wba, 0); ML_SB;
        ML_LOADV(va, aka, waa, wba, 2); ML_SB; ML_KSTEP(vb, akb, wab, wbb, 1); ML_SB;
        ML_LOADV(vb, akb, wab, wbb, 3); ML_SB; ML_KSTEP(va, aka, waa, wba, 2); ML_SB;
        ML_KSTEP(vb, akb, wab, wbb, 3); ML_SB;
#undef ML_SB
#undef ML_VM_ST
#undef ML_VM_K
#undef ML_VM_V
#undef ML_VM_Q
#undef ML_LOADK
#undef ML_MMAK
#undef ML_LOADC
#undef ML_MMAC
#undef ML_LOADV
#undef ML_KSTEP
        const float den = __shfl(nm[4][0], lr);
        const float inv = 1.f / fmaxf(fabsf(den), __expf(-mt));
#pragma unroll
        for (int a = 0; a < 2; ++a) hold[a] = (v4u){pk2(nm[2 * a][0] * inv, nm[2 * a][1] * inv), pk2(nm[2 * a][2] * inv, nm[2 * a][3] * inv), pk2(nm[2 * a + 1][0] * inv, nm[2 * a + 1][1] * inv), pk2(nm[2 * a + 1][2] * inv, nm[2 * a + 1][3] * inv)};
        { LAS bf16* CTn = (LAS bf16*)(F.lds + ML_CT + (buf ^ 1) * ML_CT_SZ);
#pragma unroll
            for (int i = 0; i < 5; ++i) if (i < 4 || lr == 0) { v2u o; o.x = pk2(accC[i][0], accC[i][1]); o.y = pk2(accC[i][2], accC[i][3]); *(LAS v2u*)(CTn + (16 * i + lr) * KLD + 16 * w + 4 * lq) = o; } }
        if (more && w == 0) mchain = gate_finish(gpre, bias_i, bias_f, mchain, (LAS float*)(F.lds + ML_G + (buf ^ 1) * ML_G_SZ), (LAS float*)(F.lds + ML_SC + (buf ^ 1) * 16), lane);
#pragma unroll
        for (int kk = 0; kk < 4; ++kk) bq[kk] = bqn[kk];
    }
    { const int t = 16 * tt + lr, tok = dir ? T - 1 - ((nc - 1) * 128 + t) : (nc - 1) * 128 + t;
        bf16* hp = F_HDIR + ((size_t)dir * NTOK + seqbase + tok) * MW + h * DH + 64 * eh + 8 * lq;
        *(GAS v4u*)hp = hold[0]; *(GAS v4u*)(hp + 32) = hold[1]; }
    if (!path) {
        const int l2 = fresh_lane(), lr2 = l2 & 15, lq2 = l2 >> 4;
        float* oC = F_out + (size_t)NTOK * D + (size_t)sidx * DH * DH;
#pragma unroll
        for (int i = 0; i < 4; ++i)
#pragma unroll
            for (int r = 0; r < 4; ++r) oC[(size_t)(16 * w + 4 * lq2 + r) * DH + 64 * eh + ML_EP(i, lr2)] = accC[i][r];
        if (eh == 0) {
            float* oN = F_out + (size_t)NTOK * D + (size_t)16 * 2 * NH * DH * DH + (size_t)sidx * DH;
            if (lr2 == 0) {
#pragma unroll
                for (int r = 0; r < 4; ++r) oN[16 * w + 4 * lq2 + r] = accC[4][r]; }
            if (w == 0 && l2 == 0) F_out[(size_t)NTOK * D + (size_t)16 * 2 * NH * DH * DH + (size_t)16 * 2 * NH * DH + sidx] = mchain;
        }
    }
    __syncthreads();
}
__device__ __forceinline__ void p3_mlstm(Frame& F) {
    for (int u = F.vcu; u < 768; u += F.G) {
        const int path = u < 256 ? 1 : 0, id = path ? u : u - 256, b = id >> 5, h = (id >> 2) & 7, dir = (id >> 1) & 1, eh = id & 1;
        switch (F.wave) {
            case 0: mlstm_unit<0>(F, path, b, h, dir, eh); break;
            case 1: mlstm_unit<1>(F, path, b, h, dir, eh); break;
            case 2: mlstm_unit<2>(F, path, b, h, dir, eh); break;
            case 3: mlstm_unit<3>(F, path, b, h, dir, eh); break;
            case 4: mlstm_unit<7>(F, path, b, h, dir, eh); break;
            case 5: mlstm_unit<6>(F, path, b, h, dir, eh); break;
            case 6: mlstm_unit<5>(F, path, b, h, dir, eh); break;
            default: mlstm_unit<4>(F, path, b, h, dir, eh); break;
        }
    }
}
constexpr float HMIX_SCALE = 16.f;
__device__ __forceinline__ void p4_combine(Frame& F) {
    const int lane = fresh_lane();
    const int c0 = 16 * lane;
    const int bx = blockIdx.x; int r_lo, r_hi;
    { const int rp = (NTOK + F.G - 1) / F.G; r_lo = min(NTOK, bx * rp); r_hi = min(NTOK, r_lo + rp); }
    float wn[16];
#pragma unroll
    for (int j = 0; j < 16; ++j) wn[j] = F_mnw[c0 + j] * HMIX_SCALE;
    for (int m0 = r_lo + F.wave; m0 < r_hi; m0 += 2 * NWAVES) {
        v4u a[2][2], bb[2][2], o[2][2];
#pragma unroll
        for (int q = 0; q < 2; ++q) { const int m = min(m0 + NWAVES * q, r_hi - 1);
            const GAS v4u* pf = (const GAS v4u*)(F_HDIR + (size_t)m * MW + c0);
            const GAS v4u* pb = (const GAS v4u*)(F_HDIR + ((size_t)NTOK + m) * MW + c0);
            const GAS v4u* po = (const GAS v4u*)(F_PROJ + (size_t)m * PROJ_LD + 3072 + c0);
#pragma unroll
            for (int i = 0; i < 2; ++i) { a[q][i] = pf[i]; bb[q][i] = pb[i]; o[q][i] = po[i]; } }
#pragma unroll
        for (int q = 0; q < 2; ++q) { const int m = m0 + NWAVES * q;
            float hv[16], ov[16]; float ss = 0.f;
#pragma unroll
            for (int i = 0; i < 2; ++i) {
#pragma unroll
                for (int j = 0; j < 4; ++j) { const float x0 = bflo(a[q][i][j]) + bflo(bb[q][i][j]), x1 = bfhi(a[q][i][j]) + bfhi(bb[q][i][j]); hv[8 * i + 2 * j] = x0; hv[8 * i + 2 * j + 1] = x1; ss += x0 * x0 + x1 * x1;
                    ov[8 * i + 2 * j] = bflo(o[q][i][j]); ov[8 * i + 2 * j + 1] = bfhi(o[q][i][j]); } }
            ss += __shfl_xor(ss, 1); ss += __shfl_xor(ss, 2); ss += __shfl_xor(ss, 4);
            const float rstd = rsqrtf(ss * (1.f / DH) + EPS);
            float yv[16];
#pragma unroll
            for (int j = 0; j < 16; ++j) { const float y = hv[j] * rstd * wn[j] / (1.f + __expf(-ov[j])); yv[j] = fminf(fmaxf(y, -448.f), 448.f); }
            int ow[4];
#pragma unroll
            for (int j = 0; j < 4; ++j) { const int w = __builtin_amdgcn_cvt_pk_fp8_f32(yv[4 * j], yv[4 * j + 1], 0, false); ow[j] = __builtin_amdgcn_cvt_pk_fp8_f32(yv[4 * j + 2], yv[4 * j + 3], w, true); }
            if (m < r_hi) *(GAS v4u*)((unsigned char*)F_RB + (size_t)m * D + c0) = (v4u){(unsigned)ow[0], (unsigned)ow[1], (unsigned)ow[2], (unsigned)ow[3]};
        }
    }
}
template <int WIN> __device__ __forceinline__ void pool_rows(const bf16* ub, unsigned char* pb, int ldo, int rbase, int L) {
    constexpr int HALFW = WIN / 2, NR = 16 + WIN;
#pragma unroll 1
    for (int rb = 0; rb < 4; ++rb) {
        const int r0 = rbase + 16 * rb, seg0 = (r0 / L) * L, tp0 = r0 - seg0;
        v2u x[NR];
#pragma unroll
        for (int i = 0; i < NR; ++i) { const int tp = tp0 - HALFW + i; const int tc = min(max(tp, 0), L - 1); x[i] = *(const GAS v2u*)(ub + (size_t)(seg0 + tc) * PROJ_LD); }
        float s0 = 0.f, s1 = 0.f, s2 = 0.f, s3 = 0.f;
#pragma unroll
        for (int q = 0; q < WIN; ++q) { const int tq = tp0 - HALFW + q; const float ok = (tq >= 0 && tq < L) ? 1.f : 0.f; s0 += ok * bflo(x[q].x); s1 += ok * bfhi(x[q].x); s2 += ok * bflo(x[q].y); s3 += ok * bfhi(x[q].y); }
#pragma unroll
        for (int i = 0; i < 16; ++i) { const int tp = tp0 + i;
            if (i > 0) { const int te = tp + HALFW - 1, tl = tp - HALFW - 1; const float oke = (te < L) ? 1.f : 0.f, okl = (tl >= 0) ? 1.f : 0.f; const v2u e = x[i + WIN - 1], l = x[i - 1];
                s0 += oke * bflo(e.x) - okl * bflo(l.x); s1 += oke * bfhi(e.x) - okl * bfhi(l.x); s2 += oke * bflo(e.y) - okl * bflo(l.y); s3 += oke * bfhi(e.y) - okl * bfhi(l.y); }
            const int lo = max(tp - HALFW, 0), hi = min(tp + HALFW, L); const float inv = 1.f / (float)(hi - lo); const v2u c = x[i + HALFW];
            const float y0 = (s0 * inv - bflo(c.x)) * HMIX_SCALE, y1 = (s1 * inv - bfhi(c.x)) * HMIX_SCALE, y2 = (s2 * inv - bflo(c.y)) * HMIX_SCALE, y3 = (s3 * inv - bfhi(c.y)) * HMIX_SCALE;
            int w = __builtin_amdgcn_cvt_pk_fp8_f32(fminf(fmaxf(y0, -448.f), 448.f), fminf(fmaxf(y1, -448.f), 448.f), 0, false);
            w = __builtin_amdgcn_cvt_pk_fp8_f32(fminf(fmaxf(y2, -448.f), 448.f), fminf(fmaxf(y3, -448.f), 448.f), w, true);
            *(GAS unsigned*)(pb + (size_t)(r0 + i) * ldo) = (unsigned)w; }
    }
}
__device__ __forceinline__ void p4_pool_item(Frame& F, int it) {
    const int rblk = it >> 2, g = it & 3, pm = rblk >> 2, rbase = 64 * (rblk & 3), lane = fresh_lane();
    const int L = pm < 16 ? 256 : 64;
    const bf16* ub = F_PROJ + (size_t)pm * 256 * PROJ_LD + 4096 + 256 * g + 4 * lane;
    unsigned char* pb = (unsigned char*)F_RB + (size_t)pm * 256 * D + 1024 + 256 * g + 4 * lane;
    if (g == 0) pool_rows<2>(ub, pb, D, rbase, L); else if (g == 1) pool_rows<4>(ub, pb, D, rbase, L); else if (g == 2) pool_rows<8>(ub, pb, D, rbase, L); else pool_rows<16>(ub, pb, D, rbase, L);
}
__device__ __forceinline__ f32x4 bf4(v2u w) { return (f32x4){bflo(w.x), bfhi(w.x), bflo(w.y), bfhi(w.y)}; }
__device__ __forceinline__ float sq4(f32x4 v) { return (v.x * v.x + v.y * v.y) + (v.z * v.z + v.w * v.w); }
__device__ __forceinline__ void p6_norm(Frame& F) {
    const int lane = fresh_lane();
    const bf16* MIX = F_HDIR; const bf16* MIX1 = F_MIX1;
    LAS f32x4* pA = (LAS f32x4*)(F.lds); LAS f32x4* pB = pA + D / 4; LAS f32x4* pC = pB + D / 4;
    const int rpw = (NTOK + F.G - 1) / F.G, r_lo = F.vcu * rpw, r_hi = min(NTOK, r_lo + rpw);
    int cur = r_lo; RowSeg sg;
    while (next_seg(cur, r_hi, sg)) {
        const float* mod = F_MOD + (size_t)sg.mr * 12288;
        for (int i = F.tid; i < D / 4; i += NWAVES * 64) { const f32x4 w1 = *(const f32x4*)(F_norm_w + D + 4 * i), ga = *(const f32x4*)(mod + 2 * D + 4 * i), w2 = *(const f32x4*)(F_norm_w + 2 * D + 4 * i), sc = *(const f32x4*)(mod + 4 * D + 4 * i);
            pA[i] = ga * w1; pB[i] = w2 * (sc + 1.f); pC[i] = *(const f32x4*)(mod + 3 * D + 4 * i); }
        __syncthreads();
        for (int m = sg.lo + F.wave; m < sg.hi; m += NWAVES) {
            f32x4 v[8]; v2u mm[8];
            { const GAS f32x4* xr = (const GAS f32x4*)xrow_ptr(F, m) + lane; const GAS v2u* mr = (const GAS v2u*)(MIX + (size_t)m * D) + lane;
#pragma unroll
                for (int j = 0; j < 8; ++j) { v[j] = __builtin_nontemporal_load(xr + 64 * j); mm[j] = __builtin_nontemporal_load(mr + 64 * j); } }
            f32x4 mx[8]; float sq = 0.f;
#pragma unroll
            for (int j = 0; j < 8; ++j) mx[j] = bf4(mm[j]);
            if (m >= TAIL_PM0 * 256) { const GAS v2u* m1 = (const GAS v2u*)(MIX1 + (size_t)(m - TAIL_PM0 * 256) * D) + lane;
#pragma unroll
                for (int j = 0; j < 8; ++j) mx[j] = mx[j] + bf4(m1[64 * j]); }
#pragma unroll
            for (int j = 0; j < 8; ++j) sq += sq4(mx[j]);
            const float rstd1 = rsqrtf(wave_sum(sq) * (1.f / D) + EPS);
            float s = 0.f;
#pragma unroll
            for (int j = 0; j < 8; ++j) { v[j] = v[j] + pA[lane + 64 * j] * (mx[j] * rstd1); s += sq4(v[j]); }
            const float rstd2 = rsqrtf(wave_sum(s) * (1.f / D) + EPS);
            GAS v2u* xrow = (GAS v2u*)(F_out + (size_t)m * D) + lane;
            GAS unsigned* o8 = (GAS unsigned*)((unsigned char*)F_RB + (size_t)m * D) + lane;
#pragma unroll
            for (int j = 0; j < 8; ++j) { v2u xo; xo.x = pk2(v[j].x, v[j].y); xo.y = pk2(v[j].z, v[j].w); xrow[64 * j] = xo;
                const f32x4 h = (v[j] * rstd2 * pB[lane + 64 * j] + pC[lane + 64 * j]) * H2_SCALE;
                int w = __builtin_amdgcn_cvt_pk_fp8_f32(fminf(fmaxf(h.x, -448.f), 448.f), fminf(fmaxf(h.y, -448.f), 448.f), 0, false);
                w = __builtin_amdgcn_cvt_pk_fp8_f32(fminf(fmaxf(h.z, -448.f), 448.f), fminf(fmaxf(h.w, -448.f), 448.f), w, true); o8[64 * j] = (unsigned)w; }
        }
        __syncthreads();
    }
}
__device__ __forceinline__ void p9_final(Frame& F) {
    const int lane = fresh_lane();
    const bf16* Y1 = F_Y1;
    LAS f32x4* pA = (LAS f32x4*)(F.lds);
    const int rpw = (NTOK + F.G - 1) / F.G, r_lo = F.vcu * rpw, r_hi = min(NTOK, r_lo + rpw);
    int cur = r_lo; RowSeg sg;
    while (next_seg(cur, r_hi, sg)) {
        const float* mod = F_MOD + (size_t)sg.mr * 12288;
        for (int i = F.tid; i < D / 4; i += NWAVES * 64) pA[i] = *(const f32x4*)(mod + 5 * D + 4 * i) * *(const f32x4*)(F_norm_w + 3 * D + 4 * i);
        __syncthreads();
        for (int mb = sg.lo + 2 * F.wave; mb < sg.hi; mb += 2 * NWAVES) {
            v2u xx[2][8]; v2u yy[2][8];
#pragma unroll
            for (int q = 0; q < 2; ++q) { const int m = min(mb + q, sg.hi - 1);
                const GAS v2u* xr = (const GAS v2u*)(F_out + (size_t)m * D) + lane; const GAS v2u* yr = (const GAS v2u*)(F_RB + (size_t)m * D) + lane;
#pragma unroll
                for (int j = 0; j < 8; ++j) { xx[q][j] = __builtin_nontemporal_load(xr + 64 * j); yy[q][j] = __builtin_nontemporal_load(yr + 64 * j); } }
#pragma unroll
            for (int q = 0; q < 2; ++q) { const int m = min(mb + q, sg.hi - 1);
                f32x4 yv[8]; float sq = 0.f;
#pragma unroll
                for (int j = 0; j < 8; ++j) yv[j] = bf4(yy[q][j]);
                if (m >= TAIL_PM0 * 256) { const GAS v2u* y1 = (const GAS v2u*)(Y1 + (size_t)(m - TAIL_PM0 * 256) * D) + lane;
#pragma unroll
                    for (int j = 0; j < 8; ++j) yv[j] = yv[j] + bf4(y1[64 * j]); }
#pragma unroll
                for (int j = 0; j < 8; ++j) sq += sq4(yv[j]);
                const float rstd = rsqrtf(wave_sum(sq) * (1.f / D) + EPS);
                if (mb + q < sg.hi) {
                    GAS f32x4* orow = (GAS f32x4*)(F_out + (size_t)m * D) + lane;
#pragma unroll
                    for (int j = 0; j < 8; ++j) orow[64 * j] = bf4(xx[q][j]) + pA[lane + 64 * j] * (yv[j] * rstd); } }
        }
        __syncthreads();
    }
}

__global__ void __launch_bounds__(NWAVES * 64, 2) hymba_fwd(Args args) {
    extern __shared__ __attribute__((aligned(16))) unsigned char lds[];
    Frame F;
    F.lds = (LAS unsigned char*)lds;
    F.MISC = (volatile LAS unsigned*)(F.lds + MISC_OFF);
    F.tid = threadIdx.x; F.lane = F.tid & 63; F.wave = __builtin_amdgcn_readfirstlane(F.tid >> 6);
    F.G = gridDim.x; { const int bx = blockIdx.x; F.vcu = (F.G % 8 == 0) ? (bx % 8) * (F.G / 8) + bx / 8 : bx; }
    F.a = &args;
    for (int u = F.tid; u < (LDS_BYTES - LDSCTL_OFF) / 4; u += NWAVES * 64) ((LAS unsigned*)(F.lds + LDSCTL_OFF))[u] = 0u;
    __syncthreads();
    XcdBarrier bar; bar.bar = (unsigned*)(F_ctl + CW_BAR); bar.x = 0; bar.st = nullptr;
    if (N_LAUNCHES != PER_PHASE) bar = xcd_barrier_post((unsigned*)(F_ctl + CW_BAR) + args.li * XCD_BAR_WORDS, F.MISC + 8);
#define GRID_BAR(seam) do { if (N_LAUNCHES == PER_PHASE) { if (F.tid == 0) __hip_atomic_store(F_ctl + CW_TMO, 0xBADBA0u | (unsigned)(seam), RLX_AGENT); } else { xcd_barrier(bar); } } while (0)
    const int lo = args.ph_lo, hi = args.ph_hi;
#ifndef PH_MASK
#define PH_MASK 0x3ff
#endif
#ifndef REP_MASK
#define REP_MASK 0
#endif
#define REPS(k) ((((REP_MASK) >> (k)) & 1) ? 2 : 1)
#define IN(k) ((((PH_MASK) >> (k)) & 1) && lo <= (k) && (k) < hi)
#define BOTH(k) (IN(k) && IN((k) + 1))

    if (IN(0)) { for (int rep = 0; rep < REPS(0); ++rep) { p0_mod_gemv(F); p0_transposes(F, 0, F.vcu, F.G); if (BOTH(0)) GRID_BAR(0); } }
    if (IN(1)) { for (int rep = 0; rep < REPS(1); ++rep) { p1_h1(F); if (BOTH(1)) GRID_BAR(1); } }
    if (IN(2)) {
        pg8::Gemm g{F_RB, F_WinT, D, D, D, 0x7F7F7F7Fu}; pg8::StaticOrder S; S.init(NTOK, WIN_ROWS, F.G, (int)blockIdx.x);
        pg8::EpiProj E{F_PROJ, F_GATES, NTOK};
        pg8::gemm_phase<pg8::EpiProj, pg8::StaticOrder, true, true>(F.lds + RING_OFF, g, S, E);
        { const int nun = (NTOK / 256) * (WIN_ROWS / 256), rem = nun % F.G;
          if (rem == 0) p0_transposes(F, 1, (int)blockIdx.x, F.G); else if ((int)blockIdx.x >= rem) p0_transposes(F, 1, (int)blockIdx.x - rem, F.G - rem); }
        if (BOTH(2)) GRID_BAR(2);
    }
    if (IN(3)) { for (int rep = 0; rep < REPS(3); ++rep) { p3_mlstm(F); if (BOTH(3)) GRID_BAR(3); } }
    if (IN(4)) { for (int rep = 0; rep < REPS(4); ++rep) {
        p4_combine(F);
        for (int it = F.wave * F.G + (int)blockIdx.x; it < 1280; it += NWAVES * F.G) p4_pool_item(F, it);
        __syncthreads();
        if (BOTH(4)) GRID_BAR(4); }
    }
    if (IN(5)) {
        { pg8::Gemm g{F_RB, F_WoutT, D, D, D, 0x7A7A7A7Au}; pg8::FullThenSplit S; S.init(TAIL_PM0 * 256, D, TAIL_PM0, TAIL_NM, D / 2, F.G, (int)blockIdx.x);
          pg8::EpiBf16<0, true, false> E{F_HDIR, D, F_MIX1, TAIL_PM0, 1.f};
          pg8::gemm_phase<pg8::EpiBf16<0, true, false>, pg8::FullThenSplit, true, true, true>(F.lds + RING_OFF, g, S, E); }
        if (BOTH(5)) GRID_BAR(5);
    }
    if (IN(6)) { for (int rep = 0; rep < REPS(6); ++rep) { p6_norm(F); if (BOTH(6)) GRID_BAR(6); } }
    if (IN(7)) {
        static_assert(W1_SCALE * H2_SCALE == 256.f, "sc8 below is 2^-8");
        pg8::Gemm g{F_RB, F_W1T, D, D, D, 0x7B7B7B7Bu}; pg8::StaticOrder S; S.init(NTOK, FF, F.G, (int)blockIdx.x);
        pg8::EpiF8Relu2 E{(unsigned char*)F_HFF, FF};
        pg8::gemm_phase<pg8::EpiF8Relu2, pg8::StaticOrder, true, true, true>(F.lds + RING_OFF, g, S, E);
        if (BOTH(7)) GRID_BAR(7);
    }
    if (IN(8)) {
        { pg8::Gemm g{F_HFF, F_W2T, FF, FF, FF, 0x7C7C7C7Cu}; pg8::FullThenSplit S; S.init(TAIL_PM0 * 256, D, TAIL_PM0, TAIL_NM, FF / 2, F.G, (int)blockIdx.x);
          pg8::EpiBf16<0, true, false> E{F_RB, D, F_Y1, TAIL_PM0, 1.f};
          pg8::gemm_phase<pg8::EpiBf16<0, true, false>, pg8::FullThenSplit, true, true, true>(F.lds + RING_OFF, g, S, E); }
        if (BOTH(8)) GRID_BAR(8);
    }
    if (IN(9)) { p9_final(F); }
#undef IN
#undef BOTH
}

extern "C" void kernel_launch(void* const* d_in, const int* in_sizes, int n_in, void* d_out, int out_size, void* d_ws, size_t ws_size, hipStream_t stream) {
    static int grid = 0;
    if (grid == 0) {
        if (n_in != 18 || ws_size < WS_END) { fprintf(stderr, "kernel_launch: built for 18 inputs and >= %zu bytes of workspace; got n_in %d, ws %zu; nothing launched\n", (size_t)WS_END, n_in, ws_size); grid = -1; return; }
        int dev = 0, cus = 0, per_cu = 0;
        if (hipGetDevice(&dev) != hipSuccess || hipDeviceGetAttribute(&cus, hipDeviceAttributeMultiprocessorCount, dev) != hipSuccess) { fprintf(stderr, "kernel_launch: device query failed\n"); grid = -1; return; }
        if (hipFuncSetAttribute((const void*)hymba_fwd, hipFuncAttributeMaxDynamicSharedMemorySize, LDS_BYTES) != hipSuccess) { fprintf(stderr, "kernel_launch: hipFuncSetAttribute failed\n"); grid = -1; return; }
        if (hipOccupancyMaxActiveBlocksPerMultiprocessor(&per_cu, (const void*)hymba_fwd, NWAVES * 64, LDS_BYTES) != hipSuccess || per_cu < 1)
            fprintf(stderr, "kernel_launch: note: occupancy query reports %d workgroups per CU\n", per_cu);
        (void)hipGetLastError();
        grid = cus;
    }
    if (grid < 0) return;
    if (hipMemsetAsync((char*)d_ws + WS_CTL, 0, CTL_ZERO_BYTES, stream) != hipSuccess) { fprintf(stderr, "kernel_launch: hipMemsetAsync failed\n"); return; }
    Args a{};
    for (int i = 0; i < 18; ++i) a.in[i] = (const float*)d_in[i];
    a.out = (float*)d_out; a.ws = (unsigned char*)d_ws;
    if (N_LAUNCHES == 1) {
        a.ph_lo = 0; a.ph_hi = PER_PHASE; a.li = 0;
        hipLaunchKernelGGL(hymba_fwd, dim3(grid), dim3(NWAVES * 64), LDS_BYTES, stream, a);
    } else {
        for (int li = 0; li < PER_PHASE; ++li) { a.ph_lo = li; a.ph_hi = li + 1; a.li = 0;
            hipLaunchKernelGGL(hymba_fwd, dim3(grid), dim3(NWAVES * 64), LDS_BYTES, stream, a); }
    }
    const hipError_t le = hipPeekAtLastError();
    if (le != hipSuccess) fprintf(stderr, "kernel_launch: launch failed: %s\n", hipGetErrorName(le));
}
```

```cpp
#include <hip/hip_runtime.h>
#include <cstdio>
#include <cstdint>

#ifndef MK_N_LAUNCHES
#define MK_N_LAUNCHES 1
#endif

namespace pg8 {
#define PG8_LAS __attribute__((address_space(3)))
typedef unsigned short bf16_t;
typedef short bf16x8 __attribute__((ext_vector_type(8)));
typedef float f32x4 __attribute__((ext_vector_type(4)));
typedef unsigned u32x4 __attribute__((ext_vector_type(4)));
typedef unsigned u32x2 __attribute__((ext_vector_type(2)));
typedef int v8i __attribute__((ext_vector_type(8)));
typedef int v4i __attribute__((ext_vector_type(4)));
typedef short s16x16a __attribute__((ext_vector_type(16), aligned(16)));
constexpr int BM = 256, BK = 64, HALF = 128, HTB = HALF * BK * 2, STAGE_BYTES = 8 * HTB, NXCD = 8, WGM = 8;

__host__ __device__ __forceinline__ int lds_byte(int r, int c) { const int st = (r >> 4) * 2 + (c >> 5), rr = r & 15, cc = c & 31, ob = rr * 64 + cc * 2; return st * 1024 + (ob ^ (((ob >> 9) & 1) << 5)); }
__host__ __device__ __forceinline__ void stage_rc(int b, int& R, int& C) { const int st = b / 1024, sb = b % 1024, swz = sb ^ (((sb >> 9) & 1) << 5); R = (st >> 1) * 16 + swz / 64; C = (st & 1) * 32 + (swz % 64) / 2; }
__host__ __device__ __forceinline__ int perm32(int rho) { const int n = rho >> 4, i = rho & 15; return 8 * (i >> 2) + 4 * n + (i & 3); }

struct Unit { int pm, pn, ka, kb, nk; };
struct Gemm { const bf16_t* A; const bf16_t* Bt; int K, lda, ldb; unsigned sc8; };

struct StaticOrder {
    int nM, nN, nwg, G, c;
    __host__ __device__ void init(int M, int N, int G_, int c_) { nM = M / BM; nN = N / BM; nwg = nM * nN; G = G_; c = c_; }
    __host__ __device__ bool next(int i, Unit& u) const {
        const long L = (long)i * G + c; if (L >= nwg) return false;
        int wgid = (int)L; { const int q = nwg / NXCD, r = nwg % NXCD, xcd = wgid % NXCD, off = wgid / NXCD; wgid = (xcd < r ? xcd * (q + 1) : r * (q + 1) + (xcd - r) * q) + off; }
        const int nig = WGM * nN, gid = wgid / nig, fm = gid * WGM, gsz = (nM - fm) < WGM ? (nM - fm) : WGM;
        u.pm = fm + ((wgid % nig) % gsz); u.pn = (wgid % nig) / gsz; u.ka = 0; u.kb = 0; u.nk = 0; return true;
    }
};
struct SplitTail {
    int pm0, nMt, kh_len, G, c;
    __host__ __device__ bool next(int i, Unit& u) const {
        const int ntile = nMt * 8; const long L = (long)i * G + c; if (L >= 2 * ntile) return false;
        const int kh = (int)L / ntile; int wgid = (int)L % ntile; { const int q = ntile / NXCD, xcd = wgid % NXCD, off = wgid / NXCD; wgid = xcd * q + off; }
        const int nig = WGM * 8, gid = wgid / nig, fm = gid * WGM, gsz = (nMt - fm) < WGM ? (nMt - fm) : WGM;
        u.pm = pm0 + fm + ((wgid % nig) % gsz); u.pn = (wgid % nig) / gsz; u.ka = kh * kh_len; u.kb = kh * kh_len; u.nk = kh_len; return true;
    }
};
struct FullThenSplit {
    static constexpr bool VARK = true;
    StaticOrder full; SplitTail tail; int nfull;
    __host__ __device__ void init(int Mfull, int N, int pm0, int nMt, int kh_len, int G, int c) { full.init(Mfull, N, G, c); tail = SplitTail{pm0, nMt, kh_len, G, c}; nfull = c < full.nwg ? (full.nwg - c + G - 1) / G : 0; }
    __host__ __device__ bool next(int i, Unit& u) const { return i < nfull ? full.next(i, u) : tail.next(i - nfull, u); }
};
struct OneUnit {
    Unit u;
    __host__ __device__ bool next(int i, Unit& o) const { if (i) return false; o = u; o.nk = 0; return true; }
};

typedef __bf16 bf16x2_t __attribute__((ext_vector_type(2)));
__device__ __forceinline__ unsigned cvt_pk_bf16(float lo, float hi) { const bf16x2_t v = {(__bf16)lo, (__bf16)hi}; return __builtin_bit_cast(unsigned, v); }

struct EpiProj {
    static constexpr bool PERM = true;
    bf16_t* P; float* G; int ntok;
    __device__ __forceinline__ void operator()(const f32x4 (&acc)[2][2][4][2], const Unit& u, int wr, int wc, int fr, int fq) const {
        const int row0 = u.pm * BM + wr * 64 + fr;
        if (u.pn < 20) {
            const int col0 = u.pn * BM + wc * 32 + 8 * fq;
#pragma unroll
            for (int ai = 0; ai < 2; ++ai)
#pragma unroll
                for (int m = 0; m < 4; ++m) { bf16_t* rowp = P + (size_t)(row0 + ai * HALF + m * 16) * 5120 + col0;
#pragma unroll
                    for (int bj = 0; bj < 2; ++bj) { const f32x4 v0 = acc[ai][bj][m][0], v1 = acc[ai][bj][m][1];
                        u32x4 w; w.x = cvt_pk_bf16(v0[0], v0[1]); w.y = cvt_pk_bf16(v0[2], v0[3]); w.z = cvt_pk_bf16(v1[0], v1[1]); w.w = cvt_pk_bf16(v1[2], v1[3]);
                        *(u32x4*)(rowp + bj * HALF) = w; } }
        } else if (wc == 0) {
#pragma unroll
            for (int ai = 0; ai < 2; ++ai)
#pragma unroll
                for (int m = 0; m < 4; ++m) { float* gp = G + (size_t)(8 * fq) * ntok + (row0 + ai * HALF + m * 16);
#pragma unroll
                    for (int n = 0; n < 2; ++n)
#pragma unroll
                        for (int j = 0; j < 4; ++j) gp[(size_t)(4 * n + j) * ntok] = acc[ai][0][m][n][j]; }
        }
    }
};
template <int ACT, bool SPLIT, bool SCALE = true> struct EpiBf16 {
    static constexpr bool PERM = true;
    bf16_t* O; int ldc; bf16_t* O2; int pm0; float oscale;
    __device__ __forceinline__ void operator()(const f32x4 (&acc)[2][2][4][2], const Unit& u, int wr, int wc, int fr, int fq) const {
        const int col0 = u.pn * BM + wc * 32 + 8 * fq;
        bf16_t* base = O + (size_t)(u.pm * BM + wr * 64 + fr) * ldc + col0;
        if (SPLIT) { if (u.ka != 0) base = O2 + (size_t)((u.pm - pm0) * BM + wr * 64 + fr) * ldc + col0; }
#pragma unroll
        for (int ai = 0; ai < 2; ++ai)
#pragma unroll
            for (int m = 0; m < 4; ++m) { bf16_t* rowp = base + (size_t)(ai * HALF + m * 16) * ldc;
#pragma unroll
                for (int bj = 0; bj < 2; ++bj) { f32x4 v0 = acc[ai][bj][m][0], v1 = acc[ai][bj][m][1];
                    if (SCALE) { v0 = v0 * oscale; v1 = v1 * oscale; }
                    if (ACT == 1) {
#pragma unroll
                        for (int j = 0; j < 4; ++j) { const float a = fmaxf(v0[j], 0.f), b = fmaxf(v1[j], 0.f); v0[j] = a * a; v1[j] = b * b; } }
                    u32x4 w; w.x = cvt_pk_bf16(v0[0], v0[1]); w.y = cvt_pk_bf16(v0[2], v0[3]); w.z = cvt_pk_bf16(v1[0], v1[1]); w.w = cvt_pk_bf16(v1[2], v1[3]);
                    *(u32x4*)(rowp + bj * HALF) = w; } }
    }
};

struct EpiF8Relu2 {
    static constexpr bool PERM = true;
    unsigned char* O; int ldc;
    __device__ __forceinline__ void operator()(const f32x4 (&acc)[2][2][4][2], const Unit& u, int wr, int wc, int fr, int fq) const {
        unsigned char* base = O + (size_t)(u.pm * BM + wr * 64 + fr) * ldc + u.pn * BM + wc * 64 + 16 * fq;
#pragma unroll
        for (int ai = 0; ai < 2; ++ai)
#pragma unroll
            for (int m = 0; m < 4; ++m) { unsigned w[4];
#pragma unroll
                for (int bj = 0; bj < 2; ++bj) { f32x4 v0 = acc[ai][bj][m][0], v1 = acc[ai][bj][m][1];
#pragma unroll
                    for (int j = 0; j < 4; ++j) { v0[j] = __builtin_amdgcn_fmed3f(v0[j], 0.f, 21.16f); v1[j] = __builtin_amdgcn_fmed3f(v1[j], 0.f, 21.16f); }
                    v0 = v0 * v0; v1 = v1 * v1;
                    int w0 = __builtin_amdgcn_cvt_pk_fp8_f32(v0[0], v0[1], 0, false); w0 = __builtin_amdgcn_cvt_pk_fp8_f32(v0[2], v0[3], w0, true);
                    int w1 = __builtin_amdgcn_cvt_pk_fp8_f32(v1[0], v1[1], 0, false); w1 = __builtin_amdgcn_cvt_pk_fp8_f32(v1[2], v1[3], w1, true);
                    w[2 * bj] = (unsigned)w0; w[2 * bj + 1] = (unsigned)w1; }
                *(u32x4*)(base + (size_t)(ai * HALF + m * 16) * ldc) = (u32x4){w[0], w[1], w[2], w[3]}; }
    }
};

template <class E_> constexpr bool perm16_v = false;
template <> constexpr bool perm16_v<EpiF8Relu2> = true;
template <class Epi, class Sched, bool ALIGN_EPI = false, bool SP2 = false, bool F8 = false>
__device__ __forceinline__ void gemm_phase(PG8_LAS unsigned char* lds, const Gemm g, const Sched& S, const Epi& E) {
    const int tid = threadIdx.x, wid = __builtin_amdgcn_readfirstlane(tid >> 6), lane = tid & 63, wr = wid >> 2, wc = wid & 3, fr = lane & 15, fq = lane >> 4;
    constexpr int ES = F8 ? 1 : 2;
    const int K = g.K; int nt = K * ES / (BK * 2);
    unsigned voffA[2], voffB[2];
#pragma unroll
    for (int i = 0; i < 2; ++i) { int R, C; stage_rc(tid * 16 + i * 8192, R, C);
        const int Rb = perm16_v<Epi> ? (64 * (R >> 5) + 16 * ((R >> 2) & 3) + 4 * ((R >> 4) & 1) + (R & 3)) : (Epi::PERM ? ((R & ~31) + perm32(R & 31)) : R);
        voffA[i] = (unsigned)(R * g.lda * ES + C * 2); voffB[i] = (unsigned)(Rb * g.ldb * ES + C * 2); }
    const size_t kstep = (size_t)(BK * 2);
    const size_t hstepA = (size_t)HALF * g.lda * ES, hstepB = (size_t)(perm16_v<Epi> ? 8 : HALF) * g.ldb * ES;
    const unsigned ldsw = (unsigned)wid * 1024u;
    const int aoff = lds_byte(wr * 64 + fr, fq * 8), boff = lds_byte(wc * 32 + fr, fq * 8);
#define PG8_UA(u) ((const char*)g.A + ((size_t)(u).pm * BM * g.lda + (size_t)(u).ka) * ES)
#define PG8_UB(u) ((const char*)g.Bt + ((size_t)(u).pn * BM * g.ldb + (size_t)(u).kb) * ES)
#define PG8_SA(b, h) (((b) * 2 + (h)) * HTB)
#define PG8_SB(b, h) ((4 + (b) * 2 + (h)) * HTB)
#define PG8_STAGE(bufoff, gbase, voff) do { _Pragma("unroll") for (int _i = 0; _i < 2; ++_i) \
        __builtin_amdgcn_global_load_lds((const unsigned*)((const char*)(gbase) + (voff)[_i]), (PG8_LAS unsigned*)(lds + (bufoff) + ldsw + _i * 8192), 16, 0, 0); } while (0)
#define PG8_LDA(dst, b, h) do { if constexpr (F8) { _Pragma("unroll") for (int m = 0; m < 4; ++m) dst##8[m] = __builtin_shufflevector(*(const PG8_LAS bf16x8*)(lds + PG8_SA(b, h) + aoff + m * 2048), *(const PG8_LAS bf16x8*)(lds + PG8_SA(b, h) + aoff + m * 2048 + 1024), 0, 1, 2, 3, 4, 5, 6, 7, 8, 9, 10, 11, 12, 13, 14, 15); } \
        else { _Pragma("unroll") for (int m = 0; m < 4; ++m) _Pragma("unroll") for (int k = 0; k < 2; ++k) dst[m][k] = *(const PG8_LAS bf16x8*)(lds + PG8_SA(b, h) + aoff + m * 2048 + k * 1024); } } while (0)
#define PG8_LDB(dst, b, h) do { if constexpr (F8) { _Pragma("unroll") for (int n = 0; n < 2; ++n) dst##8[n] = __builtin_shufflevector(*(const PG8_LAS bf16x8*)(lds + PG8_SB(b, h) + boff + n * 2048), *(const PG8_LAS bf16x8*)(lds + PG8_SB(b, h) + boff + n * 2048 + 1024), 0, 1, 2, 3, 4, 5, 6, 7, 8, 9, 10, 11, 12, 13, 14, 15); } \
        else { _Pragma("unroll") for (int n = 0; n < 2; ++n) _Pragma("unroll") for (int k = 0; k < 2; ++k) dst[n][k] = *(const PG8_LAS bf16x8*)(lds + PG8_SB(b, h) + boff + n * 2048 + k * 1024); } } while (0)
#define PG8_MMA(ai, bj, At, Bt) do { __builtin_amdgcn_s_setprio(1); _Pragma("unroll") for (int m = 0; m < 4; ++m) _Pragma("unroll") for (int n = 0; n < 2; ++n) { \
        if constexpr (F8) asm volatile("v_mfma_scale_f32_16x16x128_f8f6f4 %0, %1, %2, %0, %3, %3 op_sel_hi:[0,0,0]" : "+v"(acc[ai][bj][m][n]) : "v"(Bt##8[n]), "v"(At##8[m]), "v"(scv)); \
        else { _Pragma("unroll") for (int k = 0; k < 2; ++k) acc[ai][bj][m][n] = __builtin_amdgcn_mfma_f32_16x16x32_bf16(Bt[n][k], At[m][k], acc[ai][bj][m][n], 0, 0, 0); } } \
        __builtin_amdgcn_s_setprio(0); } while (0)
#define PG8_WAIT_V(n) asm volatile("s_waitcnt vmcnt(" #n ")" ::: "memory")
#define PG8_WAIT_L(n) asm volatile("s_waitcnt lgkmcnt(" #n ")" ::: "memory")
#define PG8_BAR __builtin_amdgcn_s_barrier()
#define PG8_SCHED __builtin_amdgcn_sched_barrier(0)
    Unit cur, nxt; int ui = 0; const unsigned scv = g.sc8;
    if (!S.next(0, cur)) return;
    if (cur.nk) nt = cur.nk * ES / (BK * 2);
    f32x4 acc[2][2][4][2];
#pragma unroll
    for (int a = 0; a < 2; ++a)
#pragma unroll
        for (int b = 0; b < 2; ++b)
#pragma unroll
            for (int m = 0; m < 4; ++m)
#pragma unroll
                for (int n = 0; n < 2; ++n) acc[a][b][m][n] = (f32x4){0.f, 0.f, 0.f, 0.f};
    bf16x8 At[4][2], B0[2][2], B1[2][2]; s16x16a At8[4], B08[2], B18[2];
    const char* cA = PG8_UA(cur); const char* cB = PG8_UB(cur);
    if constexpr (SP2) {
        PG8_STAGE(PG8_SB(0, 0), cB, voffB); PG8_STAGE(PG8_SB(0, 1), cB + hstepB, voffB); PG8_STAGE(PG8_SA(0, 0), cA, voffA); PG8_STAGE(PG8_SA(0, 1), cA + hstepA, voffA);
        if (wr == 1) PG8_BAR;
        PG8_WAIT_V(2); PG8_BAR;
        PG8_STAGE(PG8_SB(1, 0), cB + kstep, voffB); PG8_STAGE(PG8_SA(1, 0), cA + kstep, voffA); PG8_STAGE(PG8_SB(1, 1), cB + hstepB + kstep, voffB);
        PG8_WAIT_V(6); PG8_BAR;
    } else {
        PG8_STAGE(PG8_SB(0, 0), cB, voffB); PG8_STAGE(PG8_SA(0, 0), cA, voffA); PG8_STAGE(PG8_SB(0, 1), cB + hstepB, voffB); PG8_STAGE(PG8_SA(0, 1), cA + hstepA, voffA);
        if (wr == 1) PG8_BAR;
        PG8_WAIT_V(4); PG8_BAR;
        PG8_STAGE(PG8_SB(1, 0), cB + kstep, voffB); PG8_STAGE(PG8_SA(1, 0), cA + kstep, voffA); PG8_STAGE(PG8_SB(1, 1), cB + hstepB + kstep, voffB);
        PG8_WAIT_V(6); PG8_BAR;
    }
    for (;;) {
        const bool has_next = S.next(ui + 1, nxt);
        const char* nA = has_next ? PG8_UA(nxt) : cA; const char* nB = has_next ? PG8_UB(nxt) : cB;
        for (int t = 0; t < nt; t += 2) {
            const bool last = (t == nt - 2);
            const char* a1 = cA + (size_t)(t + 1) * kstep;
            const char* a2 = last ? nA : cA + (size_t)(t + 2) * kstep; const char* b2 = last ? nB : cB + (size_t)(t + 2) * kstep;
            const char* a3 = a2 + kstep; const char* b3 = b2 + kstep;
            if constexpr (SP2) {
            PG8_LDB(B0, 0, 0); PG8_LDB(B1, 0, 1); PG8_SCHED; PG8_LDA(At, 0, 0); PG8_STAGE(PG8_SA(1, 1), a1 + hstepA, voffA);
            PG8_WAIT_V(8); PG8_WAIT_L(0); PG8_BAR; PG8_MMA(0, 0, At, B0); PG8_MMA(0, 1, At, B1); PG8_BAR; PG8_SCHED;
            PG8_LDA(At, 0, 1); PG8_STAGE(PG8_SB(0, 0), b2, voffB); PG8_STAGE(PG8_SB(0, 1), b2 + hstepB, voffB); PG8_STAGE(PG8_SA(0, 0), a2, voffA);
            PG8_WAIT_V(8); PG8_WAIT_L(0); PG8_BAR; PG8_MMA(1, 0, At, B0); PG8_MMA(1, 1, At, B1); PG8_BAR; PG8_SCHED;
            PG8_LDB(B0, 1, 0); PG8_LDB(B1, 1, 1); PG8_SCHED; PG8_LDA(At, 1, 0); PG8_STAGE(PG8_SA(0, 1), a2 + hstepA, voffA);
            PG8_WAIT_V(8); PG8_WAIT_L(0); PG8_BAR; PG8_MMA(0, 0, At, B0); PG8_MMA(0, 1, At, B1); PG8_BAR; PG8_SCHED;
            PG8_LDA(At, 1, 1); PG8_STAGE(PG8_SB(1, 0), b3, voffB); PG8_STAGE(PG8_SB(1, 1), b3 + hstepB, voffB); PG8_STAGE(PG8_SA(1, 0), a3, voffA);
            PG8_WAIT_V(8); PG8_WAIT_L(0); PG8_BAR; PG8_MMA(1, 0, At, B0); PG8_MMA(1, 1, At, B1); PG8_BAR; PG8_SCHED;
            } else {
            PG8_LDB(B0, 0, 0); PG8_SCHED; PG8_LDA(At, 0, 0); PG8_STAGE(PG8_SA(1, 1), a1 + hstepA, voffA);
            PG8_WAIT_L(8); PG8_BAR; PG8_WAIT_L(0); PG8_MMA(0, 0, At, B0); PG8_BAR; PG8_SCHED;
            PG8_LDB(B1, 0, 1); PG8_STAGE(PG8_SB(0, 0), b2, voffB);
            PG8_BAR; PG8_WAIT_L(0); PG8_MMA(0, 1, At, B1); PG8_BAR;
            PG8_LDA(At, 0, 1); PG8_STAGE(PG8_SA(0, 0), a2, voffA);
            PG8_BAR; PG8_WAIT_L(0); PG8_MMA(1, 0, At, B0); PG8_BAR; PG8_SCHED;
            PG8_STAGE(PG8_SB(0, 1), b2 + hstepB, voffB);
            PG8_WAIT_V(6); PG8_BAR; PG8_MMA(1, 1, At, B1); PG8_BAR;
            PG8_LDB(B0, 1, 0); PG8_SCHED; PG8_LDA(At, 1, 0); PG8_STAGE(PG8_SA(0, 1), a2 + hstepA, voffA);
            PG8_WAIT_L(8); PG8_BAR; PG8_WAIT_L(0); PG8_MMA(0, 0, At, B0); PG8_BAR; PG8_SCHED;
            PG8_LDB(B1, 1, 1); PG8_STAGE(PG8_SB(1, 0), b3, voffB);
            PG8_BAR; PG8_WAIT_L(0); PG8_MMA(0, 1, At, B1); PG8_BAR;
            PG8_LDA(At, 1, 1); PG8_STAGE(PG8_SA(1, 0), a3, voffA);
            PG8_BAR; PG8_WAIT_L(0); PG8_MMA(1, 0, At, B0); PG8_BAR; PG8_SCHED;
            PG8_STAGE(PG8_SB(1, 1), b3 + hstepB, voffB);
            PG8_WAIT_V(6); PG8_BAR; PG8_MMA(1, 1, At, B1); PG8_BAR;
            }
        }
        if constexpr (ALIGN_EPI) { if (wr == 0) PG8_BAR; }
        if constexpr (F8) asm volatile("s_nop 15\n\ts_nop 15" ::: "memory");
        E(acc, cur, wr, wc, fr, fq);
        if (!has_next) break;
#pragma unroll
        for (int a = 0; a < 2; ++a)
#pragma unroll
            for (int b = 0; b < 2; ++b)
#pragma unroll
                for (int m = 0; m < 4; ++m)
#pragma unroll
                    for (int n = 0; n < 2; ++n) acc[a][b][m][n] = (f32x4){0.f, 0.f, 0.f, 0.f};
        cur = nxt; cA = nA; cB = nB; ++ui; nt = (cur.nk ? cur.nk : K) * ES / (BK * 2);
        if constexpr (ALIGN_EPI) { if (wr == 1) PG8_BAR; }
    }
    PG8_WAIT_V(0);
    if constexpr (!ALIGN_EPI) { if (wr == 0) PG8_BAR; }
    PG8_BAR;
#undef PG8_UA
#undef PG8_UB
#undef PG8_SA
#undef PG8_SB
#undef PG8_STAGE
#undef PG8_LDA
#undef PG8_LDB
#undef PG8_MMA
#undef PG8_WAIT_V
#undef PG8_WAIT_L
#undef PG8_BAR
#undef PG8_SCHED
}
}

constexpr int NWAVES = 8;
constexpr int N_LAUNCHES = MK_N_LAUNCHES;
constexpr int PER_PHASE = 10;
constexpr int D = 2048, NCTX = 16 * 256, NLAT = 8 * 2048, NTOK = NCTX + NLAT;
constexpr int MW = 1024, NH = 8, DH = 128, PW = 1024, FF = 8192;
constexpr int PROJ_LD = 5120;
constexpr int WIN_ROWS = 5376;
constexpr float EPS = 1e-6f;
constexpr int NMOD = 9;

constexpr size_t MiB = 1u << 20;
constexpr size_t WS_CTL = 0, CTL_ZERO_BYTES = 32 * 1024;
constexpr size_t WS_MOD = 1 * MiB;
constexpr size_t WS_GATES = 2 * MiB;
constexpr int TAIL_PM0 = 64, TAIL_NM = 16;
constexpr size_t WS_POOLWT = 11 * MiB;
constexpr size_t WS_WU = 5 * MiB;
constexpr size_t WS_WIN = 12 * MiB;
constexpr size_t WS_WOUT = 33 * MiB;
constexpr size_t WS_W1 = 41 * MiB;
constexpr size_t WS_W2 = 73 * MiB;
constexpr size_t WS_RB = 108 * MiB;
constexpr size_t WS_PROJ = 188 * MiB;
constexpr size_t WS_HDIR = 388 * MiB;
constexpr size_t WS_PP = 468 * MiB;
constexpr size_t WS_HFF = 188 * MiB;
constexpr size_t WS_END = 508 * MiB;
constexpr int CW_TMO = 0, CW_CODE = 1;
constexpr int CW_BAR = 4096;

constexpr int RING_OFF = 0;
constexpr int KLD = 144, VLD = 80;
constexpr int ML_KB = 0, ML_KB_SZ = 36864;
constexpr int ML_VB = 73728, ML_VB_SZ = 20480;
constexpr int ML_CT = 114688, ML_CT_SZ = 18944;
constexpr int ML_G = 154112, ML_G_SZ = 2048;
constexpr int ML_SC = 158208;
constexpr int LDSCTL_OFF = 158720, MISC_OFF = LDSCTL_OFF + 320;
constexpr int LDS_BYTES = 159744;

#define GAS __attribute__((address_space(1)))
#define LAS __attribute__((address_space(3)))
typedef unsigned short bf16;
typedef unsigned v4u __attribute__((ext_vector_type(4)));
typedef unsigned v2u __attribute__((ext_vector_type(2)));
typedef float f32x4 __attribute__((ext_vector_type(4)));
typedef short bf16x8 __attribute__((ext_vector_type(8)));
typedef GAS unsigned gu32;
#define RLX_AGENT __ATOMIC_RELAXED, __HIP_MEMORY_SCOPE_AGENT
#define LDS_WAIT() asm volatile("s_waitcnt lgkmcnt(0)" ::: "memory")
#define VM_WAIT() asm volatile("s_waitcnt vmcnt(0)" ::: "memory")
typedef __bf16 bf16x2_t __attribute__((ext_vector_type(2)));
__device__ __forceinline__ unsigned pk2(float lo, float hi) { const bf16x2_t v = {(__bf16)lo, (__bf16)hi}; return __builtin_bit_cast(unsigned, v); }
__device__ __forceinline__ float bflo(unsigned w) { return __uint_as_float(w << 16); }
__device__ __forceinline__ float bfhi(unsigned w) { return __uint_as_float(w & 0xffff0000u); }
__device__ __forceinline__ float bf2f(bf16 b) { return __uint_as_float((unsigned)b << 16); }

#define XB_TMO      128
#define XB_XCNT(j)  (256  + 64 * (j))
#define XB_XSUB(j)  (1280 + 64 * (j))
#define XB_XGEN(j)  (2304 + 64 * (j))
#define XB_TOP      3328
#define XB_TOPGEN   3392
#define XCD_BAR_WORDS 3456
#define XB_SPIN_CAP (1u << 18)
__device__ __forceinline__ unsigned xb_ld(unsigned* p)              { return __hip_atomic_load(p, __ATOMIC_RELAXED, __HIP_MEMORY_SCOPE_AGENT); }
__device__ __forceinline__ unsigned xb_add(unsigned* p, unsigned v) { return __hip_atomic_fetch_add(p, v, __ATOMIC_RELAXED, __HIP_MEMORY_SCOPE_AGENT); }
__device__ __forceinline__ unsigned xb_xcc_id() { return (unsigned)__builtin_amdgcn_s_getreg((3 << 11) | 20) & 0xFu; }
#define XB_SPIN(cond, bar) do { unsigned _sp = 0; while (cond) { __builtin_amdgcn_s_sleep(1); \
    if ((++_sp & 255u) == 0u) { if (xb_ld(&(bar)[XB_TMO])) break; if (_sp > XB_SPIN_CAP) { atomicAdd(&(bar)[XB_TMO], 1u); break; } } } } while (0)
struct XcdBarrier { unsigned* bar; unsigned x; volatile LAS unsigned* st; };
__device__ __forceinline__ XcdBarrier xcd_barrier_post(unsigned* bar, volatile LAS unsigned* st) {
    XcdBarrier b; b.bar = bar; b.x = xb_xcc_id(); b.st = st;
    if (threadIdx.x == 0) (void)xb_add(&bar[XB_XCNT(b.x)], 1u);
    return b;
}
__device__ __forceinline__ void xcd_barrier_complete(unsigned* bar, unsigned x, unsigned& nloc, unsigned& nx) {
    const unsigned G = gridDim.x * gridDim.y * gridDim.z;
    unsigned sum, cnt, mine, sp = 0u;
    for (;;) {
        sum = 0u; cnt = 0u; mine = 0u;
#pragma unroll
        for (unsigned j = 0; j < 16; ++j) { const unsigned c = xb_ld(&bar[XB_XCNT(j)]); sum += c; cnt += (c > 0u) ? 1u : 0u; mine = (j == x) ? c : mine; }
        if (sum == G) break;
        __builtin_amdgcn_s_sleep(1);
        if ((++sp & 255u) == 0u) { if (xb_ld(&bar[XB_TMO])) break; if (sp > XB_SPIN_CAP) { atomicAdd(&bar[XB_TMO], 1u); break; } }
    }
    nloc = mine > 0u ? mine : 1u; nx = cnt > 0u ? cnt : 1u;
}
__device__ __forceinline__ void xcd_barrier(const XcdBarrier& b) {
    asm volatile("s_waitcnt vmcnt(0)" ::: "memory");
    __syncthreads();
    if (threadIdx.x == 0) {
        unsigned* bar = b.bar;
        __builtin_amdgcn_s_waitcnt(0);
        unsigned nloc = b.st[0], nx = b.st[1];
        if (nloc == 0u) { xcd_barrier_complete(bar, b.x, nloc, nx); b.st[0] = nloc; b.st[1] = nx; }
        const unsigned old = xb_add(&bar[XB_XSUB(b.x)], 1u);
        const unsigned gen = old / nloc;
        if (old + 1u == (gen + 1u) * nloc) {
            __builtin_amdgcn_fence(__ATOMIC_RELEASE, "agent");
            asm volatile("s_waitcnt vmcnt(0)" ::: "memory");
            const unsigned og = xb_add(&bar[XB_TOP], 1u);
            const unsigned tg = og / nx;
            if (og + 1u == (tg + 1u) * nx) xb_add(&bar[XB_TOPGEN], 1u);
            else XB_SPIN(xb_ld(&bar[XB_TOPGEN]) == tg, bar);
            __builtin_amdgcn_fence(__ATOMIC_ACQUIRE, "agent");
            xb_add(&bar[XB_XGEN(b.x)], 1u);
            asm volatile("s_waitcnt vmcnt(0)" ::: "memory");
        } else {
            XB_SPIN(xb_ld(&bar[XB_XGEN(b.x)]) == gen, bar);
            __builtin_amdgcn_fence(__ATOMIC_ACQUIRE, "agent");
            asm volatile("s_waitcnt vmcnt(0)" ::: "memory");
        }
    }
    __syncthreads();
}

struct Args { const float* in[18]; float* out; unsigned char* ws; int ph_lo, ph_hi, li, pad; };
struct Frame {
    LAS unsigned char* lds;
    volatile LAS unsigned* MISC;
    int tid, lane, wave;
    int vcu, G;
    const Args* a;
};
#define F_xp (F.a->in[0])
#define F_xs (F.a->in[1])
#define F_cc (F.a->in[2])
#define F_stC (F.a->in[3])
#define F_stN (F.a->in[4])
#define F_stM (F.a->in[5])
#define F_cctx (F.a->in[6])
#define F_w_in (F.a->in[7])
#define F_gate_bias (F.a->in[8])
#define F_mnw (F.a->in[9])
#define F_pool_w (F.a->in[10])
#define F_pool_scale (F.a->in[11])
#define F_w_out (F.a->in[12])
#define F_ada_w (F.a->in[13])
#define F_ada_b (F.a->in[14])
#define F_norm_w (F.a->in[15])
#define F_w1 (F.a->in[16])
#define F_w2 (F.a->in[17])
#define F_out (F.a->out)
#define F_ctl ((gu32*)(F.a->ws + WS_CTL))
#define F_MOD ((float*)(F.a->ws + WS_MOD))
#define F_GATES ((float*)(F.a->ws + WS_GATES))
#define F_MIX1 ((bf16*)(F.a->ws + WS_PP))
#define F_Y1 ((bf16*)(F.a->ws + WS_WIN))
#define F_PoolWT ((bf16*)(F.a->ws + WS_POOLWT))
#define F_WU ((bf16*)(F.a->ws + WS_WU))
#define F_WinT ((bf16*)(F.a->ws + WS_WIN))
#define F_WoutT ((bf16*)(F.a->ws + WS_WOUT))
#define F_W1T ((bf16*)(F.a->ws + WS_W1))
#define F_W2T ((bf16*)(F.a->ws + WS_W2))
#define F_RB ((bf16*)(F.a->ws + WS_RB))
#define F_PROJ ((bf16*)(F.a->ws + WS_PROJ))
#define F_HDIR ((bf16*)(F.a->ws + WS_HDIR))
#define F_HFF ((bf16*)(F.a->ws + WS_HFF))

__device__ __forceinline__ int fresh_lane() { int l; asm volatile("v_mbcnt_lo_u32_b32 %0, -1, 0\n\tv_mbcnt_hi_u32_b32 %0, -1, %0" : "=v"(l)); return l; }
__device__ __forceinline__ float wave_sum(float v) {
#pragma unroll
    for (int o = 1; o < 64; o <<= 1) v += __shfl_xor(v, o);
    return v;
}
__device__ __forceinline__ const float* xrow_ptr(const Frame& F, int m) { return m < NCTX ? F_xp + (size_t)m * D : F_xs + (size_t)(m - NCTX) * D; }
__device__ __forceinline__ int modrow(int m) { return m < NCTX ? 0 : 1 + ((m - NCTX) >> 11); }

constexpr float W1_SCALE = 32.f, H2_SCALE = 8.f;
__device__ __forceinline__ void p0_transpose_item(const float* W, int N, bf16* WT, int ldk, int k0, int n0, int drow0, LAS float* scr, int lane, const float* nscale = nullptr, float cscale = 1.f) {
    { const int kr = lane >> 3, nq = lane & 7; f32x4 v[8];
#pragma unroll
        for (int i = 0; i < 8; ++i) v[i] = __builtin_nontemporal_load((const GAS f32x4*)(W + (size_t)(k0 + 8 * i + kr) * N + n0 + 4 * nq));
#pragma unroll
        for (int i = 0; i < 8; ++i) { LAS float* d = scr + (8 * i + kr) * 33 + 4 * nq; d[0] = v[i].x; d[1] = v[i].y; d[2] = v[i].z; d[3] = v[i].w; } }
    LDS_WAIT(); asm volatile("" ::: "memory");
    const int c = lane & 7;
#pragma unroll
    for (int j = 0; j < 4; ++j) { const int n = (lane >> 3) + 8 * j; const LAS float* s = scr + (8 * c) * 33 + n;
        const float sc = (nscale ? nscale[n] : 1.f) * cscale;
        v4u o; o.x = pk2(s[0 * 33] * sc, s[1 * 33] * sc); o.y = pk2(s[2 * 33] * sc, s[3 * 33] * sc); o.z = pk2(s[4 * 33] * sc, s[5 * 33] * sc); o.w = pk2(s[6 * 33] * sc, s[7 * 33] * sc);
        *(GAS v4u*)(WT + (size_t)(drow0 + n) * ldk + k0 + 8 * c) = o; }
    LDS_WAIT(); asm volatile("" ::: "memory");
}
__device__ __forceinline__ void p0_transpose_item_f8(const float* W, int N, unsigned char* WT, int ldk, int k0, int n0, LAS float* scr, int lane, float sc) {
    { const int kr = lane >> 3, nq = lane & 7; f32x4 v[8];
#pragma unroll
        for (int i = 0; i < 8; ++i) v[i] = __builtin_nontemporal_load((const GAS f32x4*)(W + (size_t)(k0 + 8 * i + kr) * N + n0 + 4 * nq));
#pragma unroll
        for (int i = 0; i < 8; ++i) { LAS float* d = scr + (8 * i + kr) * 33 + 4 * nq; d[0] = v[i].x; d[1] = v[i].y; d[2] = v[i].z; d[3] = v[i].w; } }
    LDS_WAIT(); asm volatile("" ::: "memory");
    const int c = lane & 7;
#pragma unroll
    for (int j = 0; j < 4; ++j) { const int n = (lane >> 3) + 8 * j; const LAS float* s = scr + (8 * c) * 33 + n;
        int w0 = __builtin_amdgcn_cvt_pk_fp8_f32(s[0 * 33] * sc, s[1 * 33] * sc, 0, false); w0 = __builtin_amdgcn_cvt_pk_fp8_f32(s[2 * 33] * sc, s[3 * 33] * sc, w0, true);
        int w1 = __builtin_amdgcn_cvt_pk_fp8_f32(s[4 * 33] * sc, s[5 * 33] * sc, 0, false); w1 = __builtin_amdgcn_cvt_pk_fp8_f32(s[6 * 33] * sc, s[7 * 33] * sc, w1, true);
        *(GAS v2u*)(WT + (size_t)(n0 + n) * ldk + k0 + 8 * c) = (v2u){(unsigned)w0, (unsigned)w1}; }
    LDS_WAIT(); asm volatile("" ::: "memory");
}
__device__ __forceinline__ void p0_transposes(Frame& F, int part, int wg, int nwg) {
    LAS float* scr = (LAS float*)(F.lds + RING_OFF + F.wave * 16384);
    const int gw = wg * NWAVES + F.wave, NGW = nwg * NWAVES;
    constexpr int I_IN = (D / 64) * (5152 / 32), I_OUT = (D / 64) * (D / 32), I_1 = (D / 64) * (FF / 32), I_2 = (FF / 64) * (D / 32), I_P = 4 * (256 / 64) * (256 / 32);
    if (part == 0) {
        constexpr int NB = 4128 / 32, I_INQ = (D / 64) * NB, I_WU = D;
        for (int it = gw; it < I_INQ + I_P + I_WU; it += NGW) { int r = it;
            if (r < I_INQ) { const int kb = r / NB, nb = r % NB, n0 = 32 * nb; const int dr = n0 < 4096 ? n0 : 5120;
                p0_transpose_item(F_w_in, 5152, F_WinT, D, 64 * kb, n0, dr, scr, F.lane, nullptr, n0 < 1024 ? 0.08838834764831845f : 1.f); continue; } r -= I_INQ;
            if (r < I_P) { const int g = r / 32, q = r % 32, kb = q / 8, nb = q % 8; p0_transpose_item(F_pool_w + (size_t)g * 65536, 256, F_PoolWT, 256, 64 * kb, 32 * nb, g * 256 + 32 * nb, scr, F.lane, F_pool_scale + g * 256 + 32 * nb); continue; } r -= I_P;
            { const GAS f32x4* s = (const GAS f32x4*)(F_w_in + (size_t)r * 5152 + 4128) + 4 * F.lane; const f32x4 a = s[0], b = s[1], c = s[2], d = s[3];
              GAS v4u* o = (GAS v4u*)(F_WU + (size_t)r * 1024) + 2 * F.lane; o[0] = (v4u){pk2(a.x, a.y), pk2(a.z, a.w), pk2(b.x, b.y), pk2(b.z, b.w)}; o[1] = (v4u){pk2(c.x, c.y), pk2(c.z, c.w), pk2(d.x, d.y), pk2(d.z, d.w)}; } }
        return;
    }
    constexpr int NITEMS = I_OUT + I_1 + I_2;
    for (int it = gw; it < NITEMS; it += NGW) {
        int r = it;
        if (r < I_OUT) { const int nblk = D / 32, kb = r / nblk, nb = r % nblk; p0_transpose_item_f8(F_w_out, D, (unsigned char*)F_WoutT, D, 64 * kb, 32 * nb, scr, F.lane, 64.f); continue; } r -= I_OUT;
        if (r < I_1) { const int nblk = FF / 32, kb = r / nblk, nb = r % nblk; p0_transpose_item_f8(F_w1, FF, (unsigned char*)F_W1T, D, 64 * kb, 32 * nb, scr, F.lane, W1_SCALE); continue; } r -= I_1;
        { const int nblk = D / 32, kb = r / nblk, nb = r % nblk; p0_transpose_item_f8(F_w2, D, (unsigned char*)F_W2T, FF, 64 * kb, 32 * nb, scr, F.lane, 64.f); }
    }
}
__device__ __forceinline__ void p0_mod_gemv(Frame& F) {
    LAS float* sil = (LAS float*)(F.lds);
    LAS float* red = (LAS float*)(F.lds + 73728);
    bool have = false;
    for (int item = F.vcu; item < 192; item += F.G) {
        if (!have) {
            { float cv[4][NMOD];
#pragma unroll
                for (int j = 0; j < 4; ++j) { const int k = F.tid + 512 * j; cv[j][0] = F_cctx[k];
#pragma unroll
                    for (int r = 1; r < NMOD; ++r) cv[j][r] = F_cc[(size_t)(r - 1) * D + k]; }
#pragma unroll
                for (int j = 0; j < 4; ++j) { const int k = F.tid + 512 * j;
#pragma unroll
                    for (int r = 0; r < NMOD; ++r) { const float c = cv[j][r]; sil[k * NMOD + r] = c / (1.f + __expf(-c)); } } }
            have = true;
        }
        __syncthreads();
        const int n0 = item * 64, kq = F.tid >> 4, c4 = F.tid & 15;
        float acc[NMOD][4];
#pragma unroll
        for (int r = 0; r < NMOD; ++r) { acc[r][0] = 0.f; acc[r][1] = 0.f; acc[r][2] = 0.f; acc[r][3] = 0.f; }
        const GAS f32x4* wp = (const GAS f32x4*)(F_ada_w + n0) + c4;
        for (int ib = 0; ib < 64; ib += 16) {
            f32x4 wv[16];
#pragma unroll
            for (int j = 0; j < 16; ++j) wv[j] = wp[(size_t)(kq + 32 * (ib + j)) * (12288 / 4)];
#pragma unroll
            for (int j = 0; j < 16; ++j) { const int k = kq + 32 * (ib + j); const f32x4 w = wv[j];
                if ((j & 3) == 0) __builtin_amdgcn_sched_barrier(0);
#pragma unroll
                for (int r = 0; r < NMOD; ++r) { const float s = sil[k * NMOD + r]; acc[r][0] += s * w.x; acc[r][1] += s * w.y; acc[r][2] += s * w.z; acc[r][3] += s * w.w; } } }
#pragma unroll
        for (int r = 0; r < NMOD; ++r)
#pragma unroll
            for (int j = 0; j < 4; ++j) { float v = acc[r][j]; v += __shfl_xor(v, 16); v += __shfl_xor(v, 32); acc[r][j] = v; }
        if (F.lane < 16) {
#pragma unroll
            for (int r = 0; r < NMOD; ++r)
#pragma unroll
                for (int j = 0; j < 4; ++j) red[(F.wave * NMOD + r) * 64 + 4 * c4 + j] = acc[r][j];
        }
        __syncthreads();
        for (int o = F.tid; o < NMOD * 64; o += NWAVES * 64) { const int r = o / 64, c = o % 64; float s = F_ada_b[n0 + c];
#pragma unroll
            for (int w = 0; w < 8; ++w) s += red[(w * NMOD + r) * 64 + c];
            F_MOD[(size_t)r * 12288 + n0 + c] = s; }
    }
    __syncthreads();
}
struct RowSeg { int lo, hi, mr; };
__device__ __forceinline__ bool next_seg(int& cur, int r_hi, RowSeg& s) {
    if (cur >= r_hi) return false;
    s.lo = cur; s.mr = modrow(cur); const int bound = s.mr == 0 ? NCTX : NCTX + s.mr * 2048; s.hi = bound < r_hi ? bound : r_hi; cur = s.hi; return true;
}
__device__ __forceinline__ void p1_h1(Frame& F) {
    const int lane = fresh_lane();
    const int bx = blockIdx.x; int r_lo, r_hi;
    if (F.G == 256) { r_lo = bx < 32 ? 66 * bx : 2112 + 82 * (bx - 32); r_hi = r_lo + (bx < 32 ? 66 : 82); } else { const int rp = (NTOK + F.G - 1) / F.G; r_lo = min(NTOK, bx * rp); r_hi = min(NTOK, r_lo + rp); }
    for (int u = bx; u < 32; u += F.G) {
        pg8::Gemm gm{F_PoolWT, F_WU, 256, 256, 1024, 0x7F7F7F7Fu};
        pg8::OneUnit S{{u >> 3, u & 7, 0, 256 * (u >> 3), 0}};
        pg8::EpiBf16<0, false> E{F_WinT + (size_t)4096 * D, D, nullptr, 0, 1.f};
        pg8::gemm_phase<pg8::EpiBf16<0, false>, pg8::OneUnit, false, true>(F.lds + RING_OFF, gm, S, E);
    }
    LAS f32x4* pA = (LAS f32x4*)(F.lds); LAS f32x4* pC = pA + D / 4;
    int cur = r_lo; RowSeg sg;
    while (next_seg(cur, r_hi, sg)) {
        const float* mod = F_MOD + (size_t)sg.mr * 12288;
        for (int i = F.tid; i < D / 4; i += NWAVES * 64) { const f32x4 w = *(const f32x4*)(F_norm_w + 4 * i), sc = *(const f32x4*)(mod + 2048 + 4 * i); pA[i] = w * (sc + 1.f); pC[i] = *(const f32x4*)(mod + 4 * i); }
        __syncthreads();
        for (int m = sg.lo + F.wave; m < sg.hi; m += NWAVES) {
            const GAS f32x4* xr = (const GAS f32x4*)xrow_ptr(F, m) + lane;
            f32x4 v[8]; float s = 0.f;
#pragma unroll
            for (int j = 0; j < 8; ++j) { v[j] = xr[64 * j]; s += (v[j].x * v[j].x + v[j].y * v[j].y) + (v[j].z * v[j].z + v[j].w * v[j].w); }
            const float rstd = rsqrtf(wave_sum(s) * (1.f / D) + EPS);
            GAS v2u* o8 = (GAS v2u*)(F_RB + (size_t)m * D) + lane;
#pragma unroll
            for (int j = 0; j < 8; ++j) { const f32x4 h = v[j] * rstd * pA[lane + 64 * j] + pC[lane + 64 * j];
                v2u o; o.x = pk2(h.x, h.y); o.y = pk2(h.z, h.w); o8[64 * j] = o; }
        }
        __syncthreads();
    }
}
typedef short s16x4 __attribute__((ext_vector_type(4)));
__device__ __forceinline__ bf16x8 tr_pair(const LAS bf16* p, int ld) {
    const s16x4 a = __builtin_amdgcn_ds_read_tr16_b64_v4i16((LAS s16x4*)p);
    const s16x4 b = __builtin_amdgcn_ds_read_tr16_b64_v4i16((LAS s16x4*)(p + 16 * ld));
    return (bf16x8){a[0], a[1], a[2], a[3], b[0], b[1], b[2], b[3]};
}
struct GatePre { float gi0, gi1, gf0, gf1; };
__device__ __forceinline__ GatePre gate_load(const float* GATES, int seqbase, int T, int dir, int c, int lane, int gi_col, int gf_col) {
    typedef float f32x2_t __attribute__((ext_vector_type(2)));
    const int j0 = c * 128 + 2 * lane, lo = dir ? T - 2 - j0 : j0;
    const f32x2_t vi = *(const GAS f32x2_t*)(GATES + (size_t)gi_col * NTOK + seqbase + lo), vf = *(const GAS f32x2_t*)(GATES + (size_t)gf_col * NTOK + seqbase + lo);
    GatePre g; g.gi0 = dir ? vi.y : vi.x; g.gi1 = dir ? vi.x : vi.y; g.gf0 = dir ? vf.y : vf.x; g.gf1 = dir ? vf.x : vf.y; return g;
}
__device__ __forceinline__ float logsig(float x) { return fminf(x, 0.f) - log1pf(__expf(-fabsf(x))); }
__device__ __forceinline__ float gate_finish(const GatePre g, float bias_i, float bias_f, float mchunk, LAS float* gb, LAS float* sc, int lane) {
    const float li0 = g.gi0 + bias_i, li1 = g.gi1 + bias_i, lf0 = logsig(g.gf0 + bias_f), lf1 = logsig(g.gf1 + bias_f);
    const float c1 = lf0 + lf1; float incl = c1;
#pragma unroll
    for (int o = 1; o < 64; o <<= 1) { const float v = __shfl_up(incl, o); if (lane >= o) incl += v; }
    const float excl = incl - c1, b0 = excl + lf0, b1 = incl;
    const float a0 = li0 - b0, a1 = li1 - b1, p1 = fmaxf(a0, a1); float im = p1;
#pragma unroll
    for (int o = 1; o < 64; o <<= 1) { const float v = __shfl_up(im, o); if (lane >= o) im = fmaxf(im, v); }
    float em = __shfl_up(im, 1); if (lane == 0) em = -INFINITY;
    const float M0 = fmaxf(mchunk, fmaxf(em, a0)), M1 = fmaxf(mchunk, im);
    const float Mlast = __shfl(M1, 63), blast = __shfl(b1, 63);
    typedef float f32x2 __attribute__((ext_vector_type(2)));
    *(LAS f32x2*)(gb + 2 * lane) = (f32x2){a0 * 1.44269504089f, a1 * 1.44269504089f};
    *(LAS f32x2*)(gb + 128 + 2 * lane) = (f32x2){M0, M1};
    *(LAS f32x2*)(gb + 256 + 2 * lane) = (f32x2){b0 + M0, b1 + M1};
    *(LAS f32x2*)(gb + 384 + 2 * lane) = (f32x2){__expf(a0 - Mlast), __expf(a1 - Mlast)};
    const float mnext = blast + Mlast;
    if (lane == 0) { sc[0] = mchunk; sc[1] = mnext; }
    return mnext;
}
#define ML_EP(i, j) (32 * ((i) >> 1) + 8 * ((j) >> 2) + 4 * ((i) & 1) + ((j) & 3))
template <int TT> __device__ __forceinline__ void mlstm_unit(Frame& F, int path, int b, int h, int dir, int eh) {
    const int T = path ? 2048 : 256, nc = T / 128, seqbase = path ? NCTX + b * 2048 : b * 256;
    constexpr int w = TT < 4 ? TT : 11 - TT, tt = TT;
    const int lane = fresh_lane(), tid = w * 64 + lane, lr = lane & 15, lq = lane >> 4, q4 = lr >> 2, p4 = lr & 3;
    const int sidx = ((b * 2 + dir) * NH + h);
    const float* GATES = F_GATES; const bf16* PROJ = F_PROJ;
    f32x4 accC[5];
#pragma unroll
    for (int i = 0; i < 5; ++i) accC[i] = (f32x4){0.f, 0.f, 0.f, 0.f};
    float m0 = 0.f;
    if (path) {
        const float* C0 = F_stC + (size_t)sidx * DH * DH;
#pragma unroll
        for (int i = 0; i < 4; ++i)
#pragma unroll
            for (int r = 0; r < 4; ++r) accC[i][r] = C0[(size_t)(16 * w + 4 * lq + r) * DH + 64 * eh + ML_EP(i, lr)];
        if (lr == 0) {
#pragma unroll
            for (int r = 0; r < 4; ++r) accC[4][r] = F_stN[(size_t)sidx * DH + 16 * w + 4 * lq + r]; }
        m0 = F_stM[sidx];
    }
    const int gi_col = (dir ? 16 : 0) + h, gf_col = (dir ? 24 : 8) + h;
    const float bias_i = F_gate_bias[gi_col], bias_f = F_gate_bias[gf_col];
    float mchain = m0;
    if (w == 0) { const GatePre g = gate_load(GATES, seqbase, T, dir, 0, lane, gi_col, gf_col);
        mchain = gate_finish(g, bias_i, bias_f, mchain, (LAS float*)(F.lds + ML_G), (LAS float*)(F.lds + ML_SC), lane); }
    { LAS bf16* CT = (LAS bf16*)(F.lds + ML_CT);
#pragma unroll
        for (int i = 0; i < 5; ++i) if (i < 4 || lr == 0) { v2u o; o.x = pk2(accC[i][0], accC[i][1]); o.y = pk2(accC[i][2], accC[i][3]); *(LAS v2u*)(CT + (16 * i + lr) * KLD + 16 * w + 4 * lq) = o; } }
    constexpr bool LDR = (w < 4); constexpr int NKL = LDR ? 8 : 0, NVL = LDR ? 4 : 0;
    const int krow = (tid & 255) >> 4, kch = tid & 15, vrow = (tid & 255) >> 3, vch = tid & 7;
    v4u kv[8], vv[4]; bf16x8 bq[4], bqn[4]; v4u hold[2];
#pragma unroll
    for (int i = 0; i < 4; ++i) { bqn[i] = (bf16x8){0, 0, 0, 0, 0, 0, 0, 0}; hold[i >> 1] = (v4u){0u, 0u, 0u, 0u}; }
    {
#pragma unroll
        for (int i = 0; i < NKL; ++i) { const int s = krow + 16 * i, stok = dir ? T - 1 - s : s; kv[i] = *(const GAS v4u*)(PROJ + (size_t)(seqbase + stok) * PROJ_LD + 1024 + h * DH + kch * 8); }
#pragma unroll
        for (int i = 0; i < NVL; ++i) { const int s = vrow + 32 * i, stok = dir ? T - 1 - s : s; vv[i] = *(const GAS v4u*)(PROJ + (size_t)(seqbase + stok) * PROJ_LD + 2048 + h * DH + 64 * eh + vch * 8); }
        const int qtok = dir ? T - 1 - (16 * tt + lr) : 16 * tt + lr; const bf16* qrow = PROJ + (size_t)(seqbase + qtok) * PROJ_LD + h * DH + 8 * lq;
#pragma unroll
        for (int kk = 0; kk < 4; ++kk) bq[kk] = *(const GAS bf16x8*)(qrow + 32 * kk); }
    if constexpr (LDR) asm volatile("" :: "v"(kv[0]), "v"(kv[1]), "v"(kv[2]), "v"(kv[3]), "v"(kv[4]), "v"(kv[5]), "v"(kv[6]), "v"(kv[7]), "v"(vv[0]), "v"(vv[1]), "v"(vv[2]), "v"(vv[3]));
    asm volatile("" :: "v"(bq[0]), "v"(bq[1]), "v"(bq[2]), "v"(bq[3]));
    const bf16x8 ones = (lr == 0) ? (bf16x8){0x3F80, 0x3F80, 0x3F80, 0x3F80, 0x3F80, 0x3F80, 0x3F80, 0x3F80} : (bf16x8){0, 0, 0, 0, 0, 0, 0, 0};
    for (int c = 0; c < nc; ++c) {
        const int buf = c & 1;
        LAS bf16* Kb = (LAS bf16*)(F.lds + ML_KB + buf * ML_KB_SZ); LAS bf16* Vb = (LAS bf16*)(F.lds + ML_VB + buf * ML_VB_SZ);
        const LAS bf16* CTb = (const LAS bf16*)(F.lds + ML_CT + buf * ML_CT_SZ);
        const LAS float* gb = (const LAS float*)(F.lds + ML_G + buf * ML_G_SZ); const LAS float* sc = (const LAS float*)(F.lds + ML_SC + buf * 16);
#pragma unroll
        for (int i = 0; i < NKL; ++i) *(LAS v4u*)(Kb + (krow + 16 * i) * KLD + kch * 8) = kv[i];
#pragma unroll
        for (int i = 0; i < NVL; ++i) { LAS bf16* vd = Vb + (vrow + 32 * i) * VLD + 32 * (vch >> 2) + 4 * (vch & 3);
            *(LAS v2u*)vd = (v2u){vv[i].x, vv[i].y}; *(LAS v2u*)(vd + 16) = (v2u){vv[i].z, vv[i].w}; }
        __syncthreads();
        const bool more = (c + 1 < nc);
        const int t = 16 * tt + lr;
        const int cn = more ? c + 1 : c, cp = c > 0 ? c - 1 : 0;
        GatePre gpre; gpre.gi0 = 0.f; gpre.gi1 = 0.f; gpre.gf0 = 0.f; gpre.gf1 = 0.f;
        if (w == 0) gpre = gate_load(GATES, seqbase, T, dir, cn, lane, gi_col, gf_col);
#define ML_VM_ST do { const int tok = dir ? T - 1 - (cp * 128 + t) : cp * 128 + t; bf16* hp = F_HDIR + ((size_t)dir * NTOK + seqbase + tok) * MW + h * DH + 64 * eh + 8 * lq; \
            *(GAS v4u*)hp = hold[0]; *(GAS v4u*)(hp + 32) = hold[1]; } while (0)
#define ML_VM_K(i0) do { if constexpr (LDR) { _Pragma("unroll") for (int i = (i0); i < (i0) + 2; ++i) { const int s = cn * 128 + krow + 16 * i, stok = dir ? T - 1 - s : s; \
            kv[i] = *(const GAS v4u*)(PROJ + (size_t)(seqbase + stok) * PROJ_LD + 1024 + h * DH + kch * 8); } } } while (0)
#define ML_VM_V(i0) do { if constexpr (LDR) { _Pragma("unroll") for (int i = (i0); i < (i0) + 2; ++i) { const int s = cn * 128 + vrow + 32 * i, stok = dir ? T - 1 - s : s; \
            vv[i] = *(const GAS v4u*)(PROJ + (size_t)(seqbase + stok) * PROJ_LD + 2048 + h * DH + 64 * eh + vch * 8); } } } while (0)
#define ML_VM_Q(k0) do { const int qtok = dir ? T - 1 - (cn * 128 + t) : cn * 128 + t; const bf16* qrow = PROJ + (size_t)(seqbase + qtok) * PROJ_LD + h * DH + 8 * lq; \
            _Pragma("unroll") for (int kk = (k0); kk < (k0) + 2; ++kk) bqn[kk] = *(const GAS bf16x8*)(qrow + 32 * kk); } while (0)
        const float Mt = gb[128 + t], mt = gb[256 + t], Mlast = gb[128 + 127], mcur = sc[0];
#define ML_SB __builtin_amdgcn_sched_barrier(0)
#define ML_LOADK(dst, kk) do { _Pragma("unroll") for (int si = 0; si < 8; ++si) if (si <= tt) dst[si] = *(const LAS bf16x8*)(Kb + (16 * si + lr) * KLD + 32 * (kk) + 8 * lq); } while (0)
#define ML_MMAK(src, kk) do { _Pragma("unroll") for (int si = 0; si < 8; ++si) if (si <= tt) st[si] = __builtin_amdgcn_mfma_f32_16x16x32_bf16(src[si], bq[kk], st[si], 0, 0, 0); } while (0)
#define ML_LOADC(dst, kk) do { _Pragma("unroll") for (int i = 0; i < 5; ++i) dst[i] = *(const LAS bf16x8*)(CTb + (16 * i + lr) * KLD + 32 * (kk) + 8 * lq); } while (0)
#define ML_MMAC(src, kk) do { _Pragma("unroll") for (int i = 0; i < 5; ++i) nm[i] = __builtin_amdgcn_mfma_f32_16x16x32_bf16(src[i], bq[kk], nm[i], 0, 0, 0); } while (0)
#define ML_LOADV(vf, ak, wa, wb, kk) do { _Pragma("unroll") for (int i = 0; i < 4; ++i) vf[i] = tr_pair(Vb + (32 * (kk) + 4 * lq + q4) * VLD + 16 * i + 4 * p4, VLD); \
            ak = tr_pair(Kb + (32 * (kk) + 4 * lq + q4) * KLD + 16 * w + 4 * p4, KLD); \
            wa = *(const LAS f32x4*)(gb + 384 + 32 * (kk) + 4 * lq); wb = *(const LAS f32x4*)(gb + 384 + 32 * (kk) + 16 + 4 * lq); } while (0)
#define ML_KSTEP(vf, ak, wa, wb, kk) do { \
            if (2 * (kk) <= tt) { \
                _Pragma("unroll") for (int i = 0; i < 4; ++i) nm[i] = __builtin_amdgcn_mfma_f32_16x16x32_bf16(vf[i], bp[kk], nm[i], 0, 0, 0); \
                nm[4] = __builtin_amdgcn_mfma_f32_16x16x32_bf16(ones, bp[kk], nm[4], 0, 0, 0); } \
            const v4u ar = __builtin_bit_cast(v4u, ak); \
            const v4u aw = (v4u){pk2(bflo(ar[0]) * wa[0], bfhi(ar[0]) * wa[1]), pk2(bflo(ar[1]) * wa[2], bfhi(ar[1]) * wa[3]), pk2(bflo(ar[2]) * wb[0], bfhi(ar[2]) * wb[1]), pk2(bflo(ar[3]) * wb[2], bfhi(ar[3]) * wb[3])}; \
            const bf16x8 akw = __builtin_bit_cast(bf16x8, aw); \
            _Pragma("unroll") for (int i = 0; i < 4; ++i) accC[i] = __builtin_amdgcn_mfma_f32_16x16x32_bf16(akw, vf[i], accC[i], 0, 0, 0); \
            accC[4] = __builtin_amdgcn_mfma_f32_16x16x32_bf16(akw, ones, accC[4], 0, 0, 0); } while (0)
        f32x4 st[8], nm[5];
#pragma unroll
        for (int si = 0; si < 8; ++si) st[si] = (f32x4){0.f, 0.f, 0.f, 0.f};
#pragma unroll
        for (int i = 0; i < 5; ++i) nm[i] = (f32x4){0.f, 0.f, 0.f, 0.f};
        bf16x8 va[4], vb[4], aka, akb; f32x4 waa, wba, wab, wbb; f32x4 av[8];
        {
            bf16x8 fa[8], fb[8];
            ML_LOADK(fa, 0); ML_SB; ML_LOADK(fb, 1); ML_SB; ML_MMAK(fa, 0); ML_VM_K(0); ML_SB; ML_LOADK(fa, 2); ML_SB; ML_MMAK(fb, 1); ML_VM_K(2); ML_SB; ML_LOADK(fb, 3); ML_SB; ML_MMAK(fa, 2); ML_VM_K(4); ML_SB;
            ML_LOADC(fa, 0); ML_SB; ML_MMAK(fb, 3); ML_VM_K(6); ML_SB; ML_LOADC(fb, 1); ML_SB; ML_MMAC(fa, 0); ML_VM_V(0); ML_VM_Q(0); ML_SB; ML_LOADC(fa, 2); ML_SB; ML_MMAC(fb, 1); ML_VM_V(2); ML_VM_Q(2); ML_SB; ML_LOADC(fb, 3); ML_SB; ML_MMAC(fa, 2); ML_VM_ST; ML_SB;
            ML_LOADV(va, aka, waa, wba, 0);
#pragma unroll
            for (int si = 0; si < 8; ++si) if (si <= tt) av[si] = *(const LAS f32x4*)(gb + 16 * si + 4 * lq);
            ML_SB; ML_MMAC(fb, 3); ML_SB;
        }
        const float gt = __expf(mcur - Mt), gs = __expf(mcur - Mlast);
#pragma unroll
        for (int i = 0; i < 5; ++i) { nm[i] = nm[i] * gt; accC[i] = accC[i] * gs; }
        const float Mt2 = Mt * 1.44269504089f;
#pragma unroll
        for (int si = 0; si < 8; ++si) if (si <= tt) {
#pragma unroll
            for (int r = 0; r < 4; ++r) { const float p = st[si][r] * __builtin_amdgcn_exp2f(av[si][r] - Mt2); st[si][r] = (si < tt || 4 * lq + r <= lr) ? p : 0.f; } }
        bf16x8 bp[4];
#pragma unroll
        for (int kk = 0; kk < 4; ++kk) { const v4u pw = (v4u){pk2(st[2 * kk][0], st[2 * kk][1]), pk2(st[2 * kk][2], st[2 * kk][3]), pk2(st[2 * kk + 1][0], st[2 * kk + 1][1]), pk2(st[2 * kk + 1][2], st[2 * kk + 1][3])};
            bp[kk] = __builtin_bit_cast(bf16x8, pw); }
        ML_SB; ML_LOADV(vb, akb, wab, wbb, 1); ML_SB; ML_KSTEP(va, aka, waa, wba, 0); ML_SB;
        ML_LOADV(va, aka, waa, wba, 2); ML_SB; ML_KSTEP(vb, akb, wab, wbb, 1); ML_SB;
        ML_LOADV(vb, akb, wab, wbb, 3); ML_SB; ML_KSTEP(va, aka, waa, wba, 2); ML_SB;
        ML_KSTEP(vb, akb, wab, wbb, 3); ML_SB;
#undef ML_SB
#undef ML_VM_ST
#undef ML_VM_K
#undef ML_VM_V
#undef ML_VM_Q
#undef ML_LOADK
#undef ML_MMAK
#undef ML_LOADC
#undef ML_MMAC
#undef ML_LOADV
#undef ML_KSTEP
        const float den = __shfl(nm[4][0], lr);
        const float inv = 1.f / fmaxf(fabsf(den), __expf(-mt));
#pragma unroll
        for (int a = 0; a < 2; ++a) hold[a] = (v4u){pk2(nm[2 * a][0] * inv, nm[2 * a][1] * inv), pk2(nm[2 * a][2] * inv, nm[2 * a][3] * inv), pk2(nm[2 * a + 1][0] * inv, nm[2 * a + 1][1] * inv), pk2(nm[2 * a + 1][2] * inv, nm[2 * a + 1][3] * inv)};
        { LAS bf16* CTn = (LAS bf16*)(F.lds + ML_CT + (buf ^ 1) * ML_CT_SZ);
#pragma unroll
            for (int i = 0; i < 5; ++i) if (i < 4 || lr == 0) { v2u o; o.x = pk2(accC[i][0], accC[i][1]); o.y = pk2(accC[i][2], accC[i][3]); *(LAS v2u*)(CTn + (16 * i + lr) * KLD + 16 * w + 4 * lq) = o; } }
        if (more && w == 0) mchain = gate_finish(gpre, bias_i, bias_f, mchain, (LAS float*)(F.lds + ML_G + (buf ^ 1) * ML_G_SZ), (LAS float*)(F.lds + ML_SC + (buf ^ 1) * 16), lane);
#pragma unroll
        for (int kk = 0; kk < 4; ++kk) bq[kk] = bqn[kk];
    }
    { const int t = 16 * tt + lr, tok = dir ? T - 1 - ((nc - 1) * 128 + t) : (nc - 1) * 128 + t;
        bf16* hp = F_HDIR + ((size_t)dir * NTOK + seqbase + tok) * MW + h * DH + 64 * eh + 8 * lq;
        *(GAS v4u*)hp = hold[0]; *(GAS v4u*)(hp + 32) = hold[1]; }
    if (!path) {
        const int l2 = fresh_lane(), lr2 = l2 & 15, lq2 = l2 >> 4;
        float* oC = F_out + (size_t)NTOK * D + (size_t)sidx * DH * DH;
#pragma unroll
        for (int i = 0; i < 4; ++i)
#pragma unroll
            for (int r = 0; r < 4; ++r) oC[(size_t)(16 * w + 4 * lq2 + r) * DH + 64 * eh + ML_EP(i, lr2)] = accC[i][r];
        if (eh == 0) {
            float* oN = F_out + (size_t)NTOK * D + (size_t)16 * 2 * NH * DH * DH + (size_t)sidx * DH;
            if (lr2 == 0) {
#pragma unroll
                for (int r = 0; r < 4; ++r) oN[16 * w + 4 * lq2 + r] = accC[4][r]; }
            if (w == 0 && l2 == 0) F_out[(size_t)NTOK * D + (size_t)16 * 2 * NH * DH * DH + (size_t)16 * 2 * NH * DH + sidx] = mchain;
        }
    }
    __syncthreads();
}
__device__ __forceinline__ void p3_mlstm(Frame& F) {
    for (int u = F.vcu; u < 768; u += F.G) {
        const int path = u < 256 ? 1 : 0, id = path ? u : u - 256, b = id >> 5, h = (id >> 2) & 7, dir = (id >> 1) & 1, eh = id & 1;
        switch (F.wave) {
            case 0: mlstm_unit<0>(F, path, b, h, dir, eh); break;
            case 1: mlstm_unit<1>(F, path, b, h, dir, eh); break;
            case 2: mlstm_unit<2>(F, path, b, h, dir, eh); break;
            case 3: mlstm_unit<3>(F, path, b, h, dir, eh); break;
            case 4: mlstm_unit<7>(F, path, b, h, dir, eh); break;
            case 5: mlstm_unit<6>(F, path, b, h, dir, eh); break;
            case 6: mlstm_unit<5>(F, path, b, h, dir, eh); break;
            default: mlstm_unit<4>(F, path, b, h, dir, eh); break;
        }
    }
}
constexpr float HMIX_SCALE = 16.f;
__device__ __forceinline__ void p4_combine(Frame& F) {
    const int lane = fresh_lane();
    const int c0 = 16 * lane;
    const int bx = blockIdx.x; int r_lo, r_hi;
    { const int rp = (NTOK + F.G - 1) / F.G; r_lo = min(NTOK, bx * rp); r_hi = min(NTOK, r_lo + rp); }
    float wn[16];
#pragma unroll
    for (int j = 0; j < 16; ++j) wn[j] = F_mnw[c0 + j] * HMIX_SCALE;
    for (int m0 = r_lo + F.wave; m0 < r_hi; m0 += 2 * NWAVES) {
        v4u a[2][2], bb[2][2], o[2][2];
#pragma unroll
        for (int q = 0; q < 2; ++q) { const int m = min(m0 + NWAVES * q, r_hi - 1);
            const GAS v4u* pf = (const GAS v4u*)(F_HDIR + (size_t)m * MW + c0);
            const GAS v4u* pb = (const GAS v4u*)(F_HDIR + ((size_t)NTOK + m) * MW + c0);
            const GAS v4u* po = (const GAS v4u*)(F_PROJ + (size_t)m * PROJ_LD + 3072 + c0);
#pragma unroll
            for (int i = 0; i < 2; ++i) { a[q][i] = pf[i]; bb[q][i] = pb[i]; o[q][i] = po[i]; } }
#pragma unroll
        for (int q = 0; q < 2; ++q) { const int m = m0 + NWAVES * q;
            float hv[16], ov[16]; float ss = 0.f;
#pragma unroll
            for (int i = 0; i < 2; ++i) {
#pragma unroll
                for (int j = 0; j < 4; ++j) { const float x0 = bflo(a[q][i][j]) + bflo(bb[q][i][j]), x1 = bfhi(a[q][i][j]) + bfhi(bb[q][i][j]); hv[8 * i + 2 * j] = x0; hv[8 * i + 2 * j + 1] = x1; ss += x0 * x0 + x1 * x1;
                    ov[8 * i + 2 * j] = bflo(o[q][i][j]); ov[8 * i + 2 * j + 1] = bfhi(o[q][i][j]); } }
            ss += __shfl_xor(ss, 1); ss += __shfl_xor(ss, 2); ss += __shfl_xor(ss, 4);
            const float rstd = rsqrtf(ss * (1.f / DH) + EPS);
            float yv[16];
#pragma unroll
            for (int j = 0; j < 16; ++j) { const float y = hv[j] * rstd * wn[j] / (1.f + __expf(-ov[j])); yv[j] = fminf(fmaxf(y, -448.f), 448.f); }
            int ow[4];
#pragma unroll
            for (int j = 0; j < 4; ++j) { const int w = __builtin_amdgcn_cvt_pk_fp8_f32(yv[4 * j], yv[4 * j + 1], 0, false); ow[j] = __builtin_amdgcn_cvt_pk_fp8_f32(yv[4 * j + 2], yv[4 * j + 3], w, true); }
            if (m < r_hi) *(GAS v4u*)((unsigned char*)F_RB + (size_t)m * D + c0) = (v4u){(unsigned)ow[0], (unsigned)ow[1], (unsigned)ow[2], (unsigned)ow[3]};
        }
    }
}
template <int WIN> __device__ __forceinline__ void pool_rows(const bf16* ub, unsigned char* pb, int ldo, int rbase, int L) {
    constexpr int HALFW = WIN / 2, NR = 16 + WIN;
#pragma unroll 1
    for (int rb = 0; rb < 4; ++rb) {
        const int r0 = rbase + 16 * rb, seg0 = (r0 / L) * L, tp0 = r0 - seg0;
        v2u x[NR];
#pragma unroll
        for (int i = 0; i < NR; ++i) { const int tp = tp0 - HALFW + i; const int tc = min(max(tp, 0), L - 1); x[i] = *(const GAS v2u*)(ub + (size_t)(seg0 + tc) * PROJ_LD); }
        float s0 = 0.f, s1 = 0.f, s2 = 0.f, s3 = 0.f;
#pragma unroll
        for (int q = 0; q < WIN; ++q) { const int tq = tp0 - HALFW + q; const float ok = (tq >= 0 && tq < L) ? 1.f : 0.f; s0 += ok * bflo(x[q].x); s1 += ok * bfhi(x[q].x); s2 += ok * bflo(x[q].y); s3 += ok * bfhi(x[q].y); }
#pragma unroll
        for (int i = 0; i < 16; ++i) { const int tp = tp0 + i;
            if (i > 0) { const int te = tp + HALFW - 1, tl = tp - HALFW - 1; const float oke = (te < L) ? 1.f : 0.f, okl = (tl >= 0) ? 1.f : 0.f; const v2u e = x[i + WIN - 1], l = x[i - 1];
                s0 += oke * bflo(e.x) - okl * bflo(l.x); s1 += oke * bfhi(e.x) - okl * bfhi(l.x); s2 += oke * bflo(e.y) - okl * bflo(l.y); s3 += oke * bfhi(e.y) - okl * bfhi(l.y); }
            const int lo = max(tp - HALFW, 0), hi = min(tp + HALFW, L); const float inv = 1.f / (float)(hi - lo); const v2u c = x[i + HALFW];
            const float y0 = (s0 * inv - bflo(c.x)) * HMIX_SCALE, y1 = (s1 * inv - bfhi(c.x)) * HMIX_SCALE, y2 = (s2 * inv - bflo(c.y)) * HMIX_SCALE, y3 = (s3 * inv - bfhi(c.y)) * HMIX_SCALE;
            int w = __builtin_amdgcn_cvt_pk_fp8_f32(fminf(fmaxf(y0, -448.f), 448.f), fminf(fmaxf(y1, -448.f), 448.f), 0, false);
            w = __builtin_amdgcn_cvt_pk_fp8_f32(fminf(fmaxf(y2, -448.f), 448.f), fminf(fmaxf(y3, -448.f), 448.f), w, true);
            *(GAS unsigned*)(pb + (size_t)(r0 + i) * ldo) = (unsigned)w; }
    }
}
__device__ __forceinline__ void p4_pool_item(Frame& F, int it) {
    const int rblk = it >> 2, g = it & 3, pm = rblk >> 2, rbase = 64 * (rblk & 3), lane = fresh_lane();
    const int L = pm < 16 ? 256 : 64;
    const bf16* ub = F_PROJ + (size_t)pm * 256 * PROJ_LD + 4096 + 256 * g + 4 * lane;
    unsigned char* pb = (unsigned char*)F_RB + (size_t)pm * 256 * D + 1024 + 256 * g + 4 * lane;
    if (g == 0) pool_rows<2>(ub, pb, D, rbase, L); else if (g == 1) pool_rows<4>(ub, pb, D, rbase, L); else if (g == 2) pool_rows<8>(ub, pb, D, rbase, L); else pool_rows<16>(ub, pb, D, rbase, L);
}
__device__ __forceinline__ f32x4 bf4(v2u w) { return (f32x4){bflo(w.x), bfhi(w.x), bflo(w.y), bfhi(w.y)}; }
__device__ __forceinline__ float sq4(f32x4 v) { return (v.x * v.x + v.y * v.y) + (v.z * v.z + v.w * v.w); }
__device__ __forceinline__ void p6_norm(Frame& F) {
    const int lane = fresh_lane();
    const bf16* MIX = F_HDIR; const bf16* MIX1 = F_MIX1;
    LAS f32x4* pA = (LAS f32x4*)(F.lds); LAS f32x4* pB = pA + D / 4; LAS f32x4* pC = pB + D / 4;
    const int rpw = (NTOK + F.G - 1) / F.G, r_lo = F.vcu * rpw, r_hi = min(NTOK, r_lo + rpw);
    int cur = r_lo; RowSeg sg;
    while (next_seg(cur, r_hi, sg)) {
        const float* mod = F_MOD + (size_t)sg.mr * 12288;
        for (int i = F.tid; i < D / 4; i += NWAVES * 64) { const f32x4 w1 = *(const f32x4*)(F_norm_w + D + 4 * i), ga = *(const f32x4*)(mod + 2 * D + 4 * i), w2 = *(const f32x4*)(F_norm_w + 2 * D + 4 * i), sc = *(const f32x4*)(mod + 4 * D + 4 * i);
            pA[i] = ga * w1; pB[i] = w2 * (sc + 1.f); pC[i] = *(const f32x4*)(mod + 3 * D + 4 * i); }
        __syncthreads();
        for (int m = sg.lo + F.wave; m < sg.hi; m += NWAVES) {
            f32x4 v[8]; v2u mm[8];
            { const GAS f32x4* xr = (const GAS f32x4*)xrow_ptr(F, m) + lane; const GAS v2u* mr = (const GAS v2u*)(MIX + (size_t)m * D) + lane;
#pragma unroll
                for (int j = 0; j < 8; ++j) { v[j] = __builtin_nontemporal_load(xr + 64 * j); mm[j] = __builtin_nontemporal_load(mr + 64 * j); } }
            f32x4 mx[8]; float sq = 0.f;
#pragma unroll
            for (int j = 0; j < 8; ++j) mx[j] = bf4(mm[j]);
            if (m >= TAIL_PM0 * 256) { const GAS v2u* m1 = (const GAS v2u*)(MIX1 + (size_t)(m - TAIL_PM0 * 256) * D) + lane;
#pragma unroll
                for (int j = 0; j < 8; ++j) mx[j] = mx[j] + bf4(m1[64 * j]); }
#pragma unroll
            for (int j = 0; j < 8; ++j) sq += sq4(mx[j]);
            const float rstd1 = rsqrtf(wave_sum(sq) * (1.f / D) + EPS);
            float s = 0.f;
#pragma unroll
            for (int j = 0; j < 8; ++j) { v[j] = v[j] + pA[lane + 64 * j] * (mx[j] * rstd1); s += sq4(v[j]); }
            const float rstd2 = rsqrtf(wave_sum(s) * (1.f / D) + EPS);
            GAS v2u* xrow = (GAS v2u*)(F_out + (size_t)m * D) + lane;
            GAS unsigned* o8 = (GAS unsigned*)((unsigned char*)F_RB + (size_t)m * D) + lane;
#pragma unroll
            for (int j = 0; j < 8; ++j) { v2u xo; xo.x = pk2(v[j].x, v[j].y); xo.y = pk2(v[j].z, v[j].w); xrow[64 * j] = xo;
                const f32x4 h = (v[j] * rstd2 * pB[lane + 64 * j] + pC[lane + 64 * j]) * H2_SCALE;
                int w = __builtin_amdgcn_cvt_pk_fp8_f32(fminf(fmaxf(h.x, -448.f), 448.f), fminf(fmaxf(h.y, -448.f), 448.f), 0, false);
                w = __builtin_amdgcn_cvt_pk_fp8_f32(fminf(fmaxf(h.z, -448.f), 448.f), fminf(fmaxf(h.w, -448.f), 448.f), w, true); o8[64 * j] = (unsigned)w; }
        }
        __syncthreads();
    }
}
__device__ __forceinline__ void p9_final(Frame& F) {
    const int lane = fresh_lane();
    const bf16* Y1 = F_Y1;
    LAS f32x4* pA = (LAS f32x4*)(F.lds);
    const int rpw = (NTOK + F.G - 1) / F.G, r_lo = F.vcu * rpw, r_hi = min(NTOK, r_lo + rpw);
    int cur = r_lo; RowSeg sg;
    while (next_seg(cur, r_hi, sg)) {
        const float* mod = F_MOD + (size_t)sg.mr * 12288;
        for (int i = F.tid; i < D / 4; i += NWAVES * 64) pA[i] = *(const f32x4*)(mod + 5 * D + 4 * i) * *(const f32x4*)(F_norm_w + 3 * D + 4 * i);
        __syncthreads();
        for (int mb = sg.lo + 2 * F.wave; mb < sg.hi; mb += 2 * NWAVES) {
            v2u xx[2][8]; v2u yy[2][8];
#pragma unroll
            for (int q = 0; q < 2; ++q) { const int m = min(mb + q, sg.hi - 1);
                const GAS v2u* xr = (const GAS v2u*)(F_out + (size_t)m * D) + lane; const GAS v2u* yr = (const GAS v2u*)(F_RB + (size_t)m * D) + lane;
#pragma unroll
                for (int j = 0; j < 8; ++j) { xx[q][j] = __builtin_nontemporal_load(xr + 64 * j); yy[q][j] = __builtin_nontemporal_load(yr + 64 * j); } }
#pragma unroll
            for (int q = 0; q < 2; ++q) { const int m = min(mb + q, sg.hi - 1);
                f32x4 yv[8]; float sq = 0.f;
#pragma unroll
                for (int j = 0; j < 8; ++j) yv[j] = bf4(yy[q][j]);
                if (m >= TAIL_PM0 * 256) { const GAS v2u* y1 = (const GAS v2u*)(Y1 + (size_t)(m - TAIL_PM0 * 256) * D) + lane;
#pragma unroll
                    for (int j = 0; j < 8; ++j) yv[j] = yv[j] + bf4(y1[64 * j]); }
#pragma unroll
                for (int j = 0; j < 8; ++j) sq += sq4(yv[j]);
                const float rstd = rsqrtf(wave_sum(sq) * (1.f / D) + EPS);
                if (mb + q < sg.hi) {
                    GAS f32x4* orow = (GAS f32x4*)(F_out + (size_t)m * D) + lane;
#pragma unroll
                    for (int j = 0; j < 8; ++j) orow[64 * j] = bf4(xx[q][j]) + pA[lane + 64 * j] * (yv[j] * rstd); } }
        }
        __syncthreads();
    }
}

__global__ void __launch_bounds__(NWAVES * 64, 2) hymba_fwd(Args args) {
    extern __shared__ __attribute__((aligned(16))) unsigned char lds[];
    Frame F;
    F.lds = (LAS unsigned char*)lds;
    F.MISC = (volatile LAS unsigned*)(F.lds + MISC_OFF);
    F.tid = threadIdx.x; F.lane = F.tid & 63; F.wave = __builtin_amdgcn_readfirstlane(F.tid >> 6);
    F.G = gridDim.x; { const int bx = blockIdx.x; F.vcu = (F.G % 8 == 0) ? (bx % 8) * (F.G / 8) + bx / 8 : bx; }
    F.a = &args;
    for (int u = F.tid; u < (LDS_BYTES - LDSCTL_OFF) / 4; u += NWAVES * 64) ((LAS unsigned*)(F.lds + LDSCTL_OFF))[u] = 0u;
    __syncthreads();
    XcdBarrier bar; bar.bar = (unsigned*)(F_ctl + CW_BAR); bar.x = 0; bar.st = nullptr;
    if (N_LAUNCHES != PER_PHASE) bar = xcd_barrier_post((unsigned*)(F_ctl + CW_BAR) + args.li * XCD_BAR_WORDS, F.MISC + 8);
#define GRID_BAR(seam) do { if (N_LAUNCHES == PER_PHASE) { if (F.tid == 0) __hip_atomic_store(F_ctl + CW_TMO, 0xBADBA0u | (unsigned)(seam), RLX_AGENT); } else { xcd_barrier(bar); } } while (0)
    const int lo = args.ph_lo, hi = args.ph_hi;
#ifndef PH_MASK
#define PH_MASK 0x3ff
#endif
#ifndef REP_MASK
#define REP_MASK 0
#endif
#define REPS(k) ((((REP_MASK) >> (k)) & 1) ? 2 : 1)
#define IN(k) ((((PH_MASK) >> (k)) & 1) && lo <= (k) && (k) < hi)
#define BOTH(k) (IN(k) && IN((k) + 1))

    if (IN(0)) { for (int rep = 0; rep < REPS(0); ++rep) { p0_mod_gemv(F); p0_transposes(F, 0, F.vcu, F.G); if (BOTH(0)) GRID_BAR(0); } }
    if (IN(1)) { for (int rep = 0; rep < REPS(1); ++rep) { p1_h1(F); if (BOTH(1)) GRID_BAR(1); } }
    if (IN(2)) {
        pg8::Gemm g{F_RB, F_WinT, D, D, D, 0x7F7F7F7Fu}; pg8::StaticOrder S; S.init(NTOK, WIN_ROWS, F.G, (int)blockIdx.x);
        pg8::EpiProj E{F_PROJ, F_GATES, NTOK};
        pg8::gemm_phase<pg8::EpiProj, pg8::StaticOrder, true, true>(F.lds + RING_OFF, g, S, E);
        { const int nun = (NTOK / 256) * (WIN_ROWS / 256), rem = nun % F.G;
          if (rem == 0) p0_transposes(F, 1, (int)blockIdx.x, F.G); else if ((int)blockIdx.x >= rem) p0_transposes(F, 1, (int)blockIdx.x - rem, F.G - rem); }
        if (BOTH(2)) GRID_BAR(2);
    }
    if (IN(3)) { for (int rep = 0; rep < REPS(3); ++rep) { p3_mlstm(F); if (BOTH(3)) GRID_BAR(3); } }
    if (IN(4)) { for (int rep = 0; rep < REPS(4); ++rep) {
        p4_combine(F);
        for (int it = F.wave * F.G + (int)blockIdx.x; it < 1280; it += NWAVES * F.G) p4_pool_item(F, it);
        __syncthreads();
        if (BOTH(4)) GRID_BAR(4); }
    }
    if (IN(5)) {
        { pg8::Gemm g{F_RB, F_WoutT, D, D, D, 0x7A7A7A7Au}; pg8::FullThenSplit S; S.init(TAIL_PM0 * 256, D, TAIL_PM0, TAIL_NM, D / 2, F.G, (int)blockIdx.x);
          pg8::EpiBf16<0, true, false> E{F_HDIR, D, F_MIX1, TAIL_PM0, 1.f};
          pg8::gemm_phase<pg8::EpiBf16<0, true, false>, pg8::FullThenSplit, true, true, true>(F.lds + RING_OFF, g, S, E); }
        if (BOTH(5)) GRID_BAR(5);
    }
    if (IN(6)) { for (int rep = 0; rep < REPS(6); ++rep) { p6_norm(F); if (BOTH(6)) GRID_BAR(6); } }
    if (IN(7)) {
        static_assert(W1_SCALE * H2_SCALE == 256.f, "sc8 below is 2^-8");
        pg8::Gemm g{F_RB, F_W1T, D, D, D, 0x7B7B7B7Bu}; pg8::StaticOrder S; S.init(NTOK, FF, F.G, (int)blockIdx.x);
        pg8::EpiF8Relu2 E{(unsigned char*)F_HFF, FF};
        pg8::gemm_phase<pg8::EpiF8Relu2, pg8::StaticOrder, true, true, true>(F.lds + RING_OFF, g, S, E);
        if (BOTH(7)) GRID_BAR(7);
    }
    if (IN(8)) {
        { pg8::Gemm g{F_HFF, F_W2T, FF, FF, FF, 0x7C7C7C7Cu}; pg8::FullThenSplit S; S.init(TAIL_PM0 * 256, D, TAIL_PM0, TAIL_NM, FF / 2, F.G, (int)blockIdx.x);
          pg8::EpiBf16<0, true, false> E{F_RB, D, F_Y1, TAIL_PM0, 1.f};
          pg8::gemm_phase<pg8::EpiBf16<0, true, false>, pg8::FullThenSplit, true, true, true>(F.lds + RING_OFF, g, S, E); }
        if (BOTH(8)) GRID_BAR(8);
    }
    if (IN(9)) { p9_final(F); }
#undef IN
#undef BOTH
}

extern "C" void kernel_launch(void* const* d_in, const int* in_sizes, int n_in, void* d_out, int out_size, void* d_ws, size_t ws_size, hipStream_t stream) {
    static int grid = 0;
    if (grid == 0) {
        if (n_in != 18 || ws_size < WS_END) { fprintf(stderr, "kernel_launch: built for 18 inputs and >= %zu bytes of workspace; got n_in %d, ws %zu; nothing launched\n", (size_t)WS_END, n_in, ws_size); grid = -1; return; }
        int dev = 0, cus = 0, per_cu = 0;
        if (hipGetDevice(&dev) != hipSuccess || hipDeviceGetAttribute(&cus, hipDeviceAttributeMultiprocessorCount, dev) != hipSuccess) { fprintf(stderr, "kernel_launch: device query failed\n"); grid = -1; return; }
        if (hipFuncSetAttribute((const void*)hymba_fwd, hipFuncAttributeMaxDynamicSharedMemorySize, LDS_BYTES) != hipSuccess) { fprintf(stderr, "kernel_launch: hipFuncSetAttribute failed\n"); grid = -1; return; }
        if (hipOccupancyMaxActiveBlocksPerMultiprocessor(&per_cu, (const void*)hymba_fwd, NWAVES * 64, LDS_BYTES) != hipSuccess || per_cu < 1)
            fprintf(stderr, "kernel_launch: note: occupancy query reports %d workgroups per CU\n", per_cu);
        (void)hipGetLastError();
        grid = cus;
    }
    if (grid < 0) return;
    if (hipMemsetAsync((char*)d_ws + WS_CTL, 0, CTL_ZERO_BYTES, stream) != hipSuccess) { fprintf(stderr, "kernel_launch: hipMemsetAsync failed\n"); return; }
    Args a{};
    for (int i = 0; i < 18; ++i) a.in[i] = (const float*)d_in[i];
    a.out = (float*)d_out; a.ws = (unsigned char*)d_ws;
    if (N_LAUNCHES == 1) {
        a.ph_lo = 0; a.ph_hi = PER_PHASE; a.li = 0;
        hipLaunchKernelGGL(hymba_fwd, dim3(grid), dim3(NWAVES * 64), LDS_BYTES, stream, a);
    } else {
        for (int li = 0; li < PER_PHASE; ++li) { a.ph_lo = li; a.ph_hi = li + 1; a.li = 0;
            hipLaunchKernelGGL(hymba_fwd, dim3(grid), dim3(NWAVES * 64), LDS_BYTES, stream, a); }
    }
    const hipError_t le = hipPeekAtLastError();
    if (le != hipSuccess) fprintf(stderr, "kernel_launch: launch failed: %s\n", hipGetErrorName(le));
}
```
